# Optimizing an MI355X kernel written in HIP

```python
import jax, jax.numpy as jnp
from jax import lax
import numpy as np

D_MODEL = 2048
BATCH = 8
SEQ = 2048
DEPTH = 1

D_MIX = D_MODEL
FOURIER_WIDTH = D_MIX // 2
N_FOURIER_GROUPS = 4
FOURIER_GROUP = FOURIER_WIDTH // N_FOURIER_GROUPS
POOL_WIDTH = D_MIX - FOURIER_WIDTH
POOL_WINDOWS = (2, 4, 8, 16)
N_POOL_GROUPS = len(POOL_WINDOWS)
POOL_GROUP = POOL_WIDTH // N_POOL_GROUPS
N_BRANCHES = 2
N_EXPERTS = 16
EXPERT_FF = 1408
CAPACITY_FACTOR = 2
EPS = 1e-6

kernel_name = "hybrid_fourier_pool_ec_moe_encoder"


def rmsnorm(x, g):
    xf = x.astype(jnp.float32)
    y = xf * lax.rsqrt(jnp.mean(xf * xf, axis=-1, keepdims=True) + EPS)
    return (y * g.astype(jnp.float32)).astype(x.dtype)


def fourier_mixer(p_f, w_mix):
    B, S, _ = p_f.shape
    z = p_f.reshape(B, S, N_FOURIER_GROUPS, FOURIER_GROUP).astype(jnp.float32)
    z = jnp.fft.fftn(z, axes=(1, 3), norm="ortho").real.astype(p_f.dtype)
    y = jnp.einsum("bsgc,gcd->bsgd", z, w_mix)
    return y.reshape(B, S, FOURIER_WIDTH)


def pool_mixer(p_p, w_mix, scale):
    B, S, _ = p_p.shape
    z = p_p.reshape(B, S, N_POOL_GROUPS, POOL_GROUP).astype(jnp.float32)
    csum = jnp.concatenate([jnp.zeros((B, 1, N_POOL_GROUPS, POOL_GROUP), jnp.float32),
                            jnp.cumsum(z, axis=1)], axis=1)
    half = jnp.array([w // 2 for w in POOL_WINDOWS], jnp.int32)
    pos = jnp.arange(S, dtype=jnp.int32)[:, None]
    lo = jnp.clip(pos - half[None, :], 0, S)
    hi = jnp.clip(pos + half[None, :], 0, S)
    g_idx = jnp.arange(N_POOL_GROUPS, dtype=jnp.int32)[None, :]
    win_sum = csum[:, hi, g_idx] - csum[:, lo, g_idx]
    count = (hi - lo).astype(jnp.float32)[None, :, :, None]
    pooled = (win_sum / count - z).astype(p_p.dtype)
    y = jnp.einsum("bsgc,gcd->bsgd", pooled, w_mix)
    return y.reshape(B, S, POOL_WIDTH) * scale


def mixer_block(u, w_in, w_fourier_mix, w_pool_mix, pool_scale, w_branch_f, w_branch_p,
                w_gate, b_gate, w_out):
    p = jnp.einsum("bsd,dm->bsm", u, w_in)
    y_f = jnp.einsum("bsm,md->bsd", fourier_mixer(p[..., :FOURIER_WIDTH], w_fourier_mix), w_branch_f)
    y_p = jnp.einsum("bsm,md->bsd", pool_mixer(p[..., FOURIER_WIDTH:], w_pool_mix, pool_scale), w_branch_p)
    gates = jax.nn.sigmoid((jnp.einsum("bsd,dk->bsk", u, w_gate) + b_gate).astype(jnp.float32)).astype(u.dtype)
    g_f, g_p = gates[..., :D_MODEL], gates[..., D_MODEL:]
    merged = g_f * y_f + g_p * y_p
    return jnp.einsum("bsd,de->bse", merged, w_out)


def expert_choice_moe(u, w_router, w_gate_e, w_up_e, w_down_e):
    B, S, D = u.shape
    cap = CAPACITY_FACTOR * S // N_EXPERTS
    logits = jnp.einsum("bsd,de->bse", u, w_router).astype(jnp.float32)
    affinity = jax.nn.softmax(logits, axis=-1)
    gate, idx = lax.top_k(jnp.swapaxes(affinity, 1, 2), cap)
    xs = jax.vmap(lambda ub, ib: ub[ib])(u, idx)
    h = jax.nn.silu(jnp.einsum("becd,edf->becf", xs, w_gate_e)) * jnp.einsum("becd,edf->becf", xs, w_up_e)
    y = jnp.einsum("becf,efd->becd", h, w_down_e) * gate[..., None].astype(u.dtype)
    combine = lambda ib, yb: jnp.zeros((S, D), yb.dtype).at[ib.reshape(-1)].add(yb.reshape(-1, D))
    return jax.vmap(combine)(idx, y)


def setup_inputs(seed: int = 0) -> dict:
    key = jax.random.key(seed)
    ks = jax.random.split(key, 20)
    f32 = jnp.float32
    nrm = lambda k, shape, fan_in: jax.random.normal(k, shape, f32) * (fan_in ** -0.5)
    L = DEPTH
    return {
        "x": jax.random.normal(ks[0], (BATCH, SEQ, D_MODEL), f32),
        "norm_mix_g": 1.0 + 0.02 * jax.random.normal(ks[1], (L, D_MODEL), f32),
        "w_in": nrm(ks[2], (L, D_MODEL, D_MIX), D_MODEL),
        "w_fourier_mix": nrm(ks[3], (L, N_FOURIER_GROUPS, FOURIER_GROUP, FOURIER_GROUP), FOURIER_GROUP),
        "w_pool_mix": nrm(ks[4], (L, N_POOL_GROUPS, POOL_GROUP, POOL_GROUP), POOL_GROUP),
        "pool_scale": 1.0 + 0.02 * jax.random.normal(ks[5], (L, POOL_WIDTH), f32),
        "w_branch_f": nrm(ks[6], (L, FOURIER_WIDTH, D_MODEL), FOURIER_WIDTH),
        "w_branch_p": nrm(ks[7], (L, POOL_WIDTH, D_MODEL), POOL_WIDTH),
        "w_gate": nrm(ks[8], (L, D_MODEL, N_BRANCHES * D_MODEL), D_MODEL),
        "b_gate": 0.02 * jax.random.normal(ks[9], (L, N_BRANCHES * D_MODEL), f32),
        "w_out": nrm(ks[10], (L, D_MODEL, D_MODEL), D_MODEL),
        "norm_moe_g": 1.0 + 0.02 * jax.random.normal(ks[11], (L, D_MODEL), f32),
        "w_router": nrm(ks[12], (L, D_MODEL, N_EXPERTS), D_MODEL),
        "w_expert_gate": nrm(ks[13], (L, N_EXPERTS, D_MODEL, EXPERT_FF), D_MODEL),
        "w_expert_up": nrm(ks[14], (L, N_EXPERTS, D_MODEL, EXPERT_FF), D_MODEL),
        "w_expert_down": nrm(ks[15], (L, N_EXPERTS, EXPERT_FF, D_MODEL), EXPERT_FF),
        "norm_final_g": 1.0 + 0.02 * jax.random.normal(ks[16], (D_MODEL,), f32),
    }


def reference(x, norm_mix_g, w_in, w_fourier_mix, w_pool_mix, pool_scale, w_branch_f, w_branch_p,
              w_gate, b_gate, w_out, norm_moe_g, w_router, w_expert_gate, w_expert_up,
              w_expert_down, norm_final_g):
    h = x
    for l in range(DEPTH):
        u = rmsnorm(h, norm_mix_g[l])
        h = h + mixer_block(u, w_in[l], w_fourier_mix[l], w_pool_mix[l], pool_scale[l],
                            w_branch_f[l], w_branch_p[l], w_gate[l], b_gate[l], w_out[l])
        v = rmsnorm(h, norm_moe_g[l])
        h = h + expert_choice_moe(v, w_router[l], w_expert_gate[l], w_expert_up[l], w_expert_down[l])
    return rmsnorm(h, norm_final_g)
```

```cpp
#include <hip/hip_runtime.h>
#include <hip/hip_cooperative_groups.h>
#include <cstdio>
#include <cstdint>
#include <cstring>
namespace cg = cooperative_groups;

#define PROBE_MASK 0u
#ifndef MK_N_LAUNCHES
#define MK_N_LAUNCHES 1
#endif

#define LAS __attribute__((address_space(3)))
typedef unsigned short bf16_t;
typedef short bf16x8 __attribute__((ext_vector_type(8)));
typedef float f32x4 __attribute__((ext_vector_type(4)));
typedef float f32x2 __attribute__((ext_vector_type(2)));
typedef unsigned u32x4 __attribute__((ext_vector_type(4)));
typedef unsigned u32x2 __attribute__((ext_vector_type(2)));
typedef int i32x4 __attribute__((ext_vector_type(4)));
typedef int i32x8 __attribute__((ext_vector_type(8)));

constexpr int BATCH = 8, SEQ = 2048, D = 2048, T = BATCH * SEQ;
constexpr int NE = 16, FF = 1408, CAP = 256, NPAN = BATCH * NE;
constexpr int FW = 1024;
constexpr int HP = 1536;
constexpr float EPS = 1e-6f;
constexpr int NWAVES = 8, NTHR = 512;
constexpr int N_STEPS = 18;

constexpr size_t MiB = 1u << 20;
constexpr size_t WS_WTIN = 2 * MiB;
constexpr size_t WS_WTG = 10 * MiB;
constexpr size_t WS_WBFT = 26 * MiB;
constexpr size_t WS_WBPT = 30 * MiB;
constexpr size_t WS_WUVP = 34 * MiB;
constexpr size_t WS_WOUT = 46 * MiB;
constexpr size_t WS_MIXC = 54 * MiB;
constexpr size_t WS_MIXS = 54 * MiB + 512 * 1024;
constexpr size_t WS_MIXP = 55 * MiB;
constexpr size_t WS_TC = 56 * MiB;
constexpr size_t WS_TS = 59 * MiB;
constexpr size_t WS_WGU = 64 * MiB;
constexpr size_t WS_WD = 152 * MiB;
constexpr size_t WS_RA = 200 * MiB;
constexpr size_t WS_RB = 264 * MiB;
constexpr size_t WS_RC = 296 * MiB;
constexpr size_t WS_PP = 328 * MiB;
constexpr size_t WS_PM = 346 * MiB;
constexpr size_t WS_RD = 364 * MiB;
constexpr size_t WS_RE = 492 * MiB;
constexpr size_t WS_AFF = 588 * MiB;
constexpr size_t WS_INV = 589 * MiB;
constexpr size_t WS_IDX = 590 * MiB;
constexpr size_t WS_GATE = 590 * MiB + 256 * 1024;
constexpr size_t WS_END = 591 * MiB;
constexpr int KU = 1152, UVZ = 3 * FW;

constexpr int LDS_BYTES = 155648;
constexpr int MISC_OFF = LDS_BYTES - 256;
constexpr size_t CTL_ZERO_BYTES = 65536;

__device__ __forceinline__ unsigned f2bf(float f) { unsigned u = __builtin_bit_cast(unsigned, f); return (u + 0x7fffu + ((u >> 16) & 1u)) >> 16; }
__device__ __forceinline__ unsigned pk2(float lo, float hi) { return f2bf(lo) | (f2bf(hi) << 16); }
__device__ __forceinline__ unsigned cvt_pk_bf16(float lo, float hi) { unsigned r; asm volatile("v_cvt_pk_bf16_f32 %0, %1, %2" : "=v"(r) : "v"(lo), "v"(hi)); return r; }
__device__ __forceinline__ float bf_lo(unsigned w) { return __builtin_bit_cast(float, w << 16); }
__device__ __forceinline__ float bf_hi(unsigned w) { return __builtin_bit_cast(float, w & 0xffff0000u); }
template <int CTRL> __device__ __forceinline__ float dpp_mov(float v) { return __builtin_bit_cast(float, __builtin_amdgcn_update_dpp(0, __builtin_bit_cast(int, v), CTRL, 0xf, 0xf, false)); }
__device__ __forceinline__ float lane_val(float v, int l) { return __builtin_bit_cast(float, __builtin_amdgcn_readlane(__builtin_bit_cast(int, v), l)); }
__device__ __forceinline__ float wave_sum(float v) {
    v += dpp_mov<0xB1>(v); v += dpp_mov<0x4E>(v); v += dpp_mov<0x141>(v); v += dpp_mov<0x140>(v);
    return (lane_val(v, 0) + lane_val(v, 16)) + (lane_val(v, 32) + lane_val(v, 48));
}
__device__ __forceinline__ float sigmoidf_fast(float x) { return __builtin_amdgcn_rcpf(1.0f + __builtin_amdgcn_exp2f(-1.4426950408889634f * x)); }
#define LDS_WAIT() asm volatile("s_waitcnt lgkmcnt(0)" ::: "memory")
#define VM_WAIT() asm volatile("s_waitcnt vmcnt(0)" ::: "memory")

constexpr int BM = 256, BK = 64, HALF = 128, HTB = HALF * BK * 2, NXCD = 8, WGM = 8;
__device__ __forceinline__ int lds_byte(int r, int c) { const int st = (r >> 4) * 2 + (c >> 5), rr = r & 15, cc = c & 31, ob = rr * 64 + cc * 2; return st * 1024 + (ob ^ (((ob >> 9) & 1) << 5)); }
__device__ __forceinline__ void stage_rc(int b, int& R, int& C) { const int st = b / 1024, sb = b % 1024, swz = sb ^ (((sb >> 9) & 1) << 5); R = (st >> 1) * 16 + swz / 64; C = (st & 1) * 32 + (swz % 64) / 2; }
__device__ __forceinline__ int perm32(int rho) { const int n = rho >> 4, i = rho & 15; return 8 * (i >> 2) + 4 * n + (i & 3); }

enum EpiMode { EPI_STORE = 0, EPI_PG = 1, EPI_GATED = 2, EPI_MIRROR = 3, EPI_SWIGLU = 5, EPI_ROWSCALE = 6 };
struct GemmDesc {
    const char* A; const char* B;
    int lda, ldb, K;
    int nM, nN, nZ;
    long sAz, sAm, sBz, sBn;
    int rz, rm;
    int mode, perm;
    int coff;
    int hook_t;
    const void* gidx;
    void* O; int ldc; long oz;
    const void* P1; const void* P2;
};
struct Unit { unsigned A, B; int row0, col0, z; };

__device__ __forceinline__ bool unit_next(const GemmDesc& d, int i, int G, int c, Unit& u) {
    if (c < 0) return false;
    const int nwg = d.nM * d.nN; const long L = (long)i * G + c;
    if (L >= (long)nwg * d.nZ) return false;
    const int z = (int)(L / nwg); int wgid = (int)(L % nwg);
    { const int q = nwg / NXCD, r = nwg % NXCD, xcd = wgid % NXCD, off = wgid / NXCD; wgid = (xcd < r ? xcd * (q + 1) : r * (q + 1) + (xcd - r) * q) + off; }
    const int nig = WGM * d.nN, gid = wgid / nig, fm = gid * WGM, gsz = (d.nM - fm) < WGM ? (d.nM - fm) : WGM;
    const int pm = fm + ((wgid % nig) % gsz), pn = (wgid % nig) / gsz;
    u.A = (unsigned)((long)z * d.sAz + (long)pm * d.sAm); u.B = (unsigned)((long)z * d.sBz + (long)pn * d.sBn);
    u.row0 = z * d.rz + pm * d.rm; u.col0 = pn * BM; u.z = z; return true;
}

__device__ __forceinline__ void epilogue(const GemmDesc& d, const f32x4 (&acc)[2][2][4][2], const Unit& u, int wr, int wc, int fr, int fq) {
    const int rowb = u.row0 + wr * 64 + fr;
    if (d.mode == EPI_STORE) {
        bf16_t* O = (bf16_t*)d.O + (size_t)u.z * d.oz; const int col0 = u.col0 + wc * 32 + 8 * fq;
#pragma unroll
        for (int ai = 0; ai < 2; ++ai)
#pragma unroll
            for (int m = 0; m < 4; ++m) { bf16_t* rowp = O + (size_t)(rowb + ai * HALF + m * 16) * d.ldc + col0;
#pragma unroll
                for (int bj = 0; bj < 2; ++bj) { const f32x4 v0 = acc[ai][bj][m][0], v1 = acc[ai][bj][m][1];
                    u32x4 w; w.x = cvt_pk_bf16(v0[0], v0[1]); w.y = cvt_pk_bf16(v0[2], v0[3]); w.z = cvt_pk_bf16(v1[0], v1[1]); w.w = cvt_pk_bf16(v1[2], v1[3]);
                    *(u32x4*)(rowp + bj * HALF) = w; } }
    } else if (d.mode == EPI_MIRROR) {
        bf16_t* O = (bf16_t*)d.O; const int col0 = u.col0 + wc * 32 + 8 * fq; const float sgn = d.oz ? -1.0f : 1.0f;
        const int kb = (u.row0 & (SEQ - 1)) + wr * 64 + fr, zb = u.row0 & ~(SEQ - 1);
#pragma unroll
        for (int ai = 0; ai < 2; ++ai)
#pragma unroll
            for (int m = 0; m < 4; ++m) { const int k = kb + ai * HALF + m * 16; bf16_t* rowp = O + (size_t)(zb + k) * UVZ + col0; bf16_t* rowm = O + (size_t)(zb + SEQ - k) * UVZ + col0;
#pragma unroll
                for (int bj = 0; bj < 2; ++bj) { const f32x4 v0 = acc[ai][bj][m][0], v1 = acc[ai][bj][m][1];
                    u32x4 w; w.x = cvt_pk_bf16(v0[0], v0[1]); w.y = cvt_pk_bf16(v0[2], v0[3]); w.z = cvt_pk_bf16(v1[0], v1[1]); w.w = cvt_pk_bf16(v1[2], v1[3]);
                    *(u32x4*)(rowp + bj * HALF) = w;
                    if (k > 0) { u32x4 x; x.x = cvt_pk_bf16(sgn * v0[0], sgn * v0[1]); x.y = cvt_pk_bf16(sgn * v0[2], sgn * v0[3]); x.z = cvt_pk_bf16(sgn * v1[0], sgn * v1[1]); x.w = cvt_pk_bf16(sgn * v1[2], sgn * v1[3]);
                        *(u32x4*)(rowm + bj * HALF) = x; } } }
    } else if (d.mode == EPI_PG) {
        if (d.perm) {
            bf16_t* O = (bf16_t*)d.O; const int col0 = u.col0 + wc * 32 + 8 * fq;
#pragma unroll
            for (int ai = 0; ai < 2; ++ai)
#pragma unroll
                for (int m = 0; m < 4; ++m) { bf16_t* rowp = O + (size_t)(rowb + ai * HALF + m * 16) * FW + col0;
#pragma unroll
                    for (int bj = 0; bj < 2; ++bj) { const f32x4 v0 = acc[ai][bj][m][0], v1 = acc[ai][bj][m][1];
                        u32x4 w; w.x = cvt_pk_bf16(v0[0], v0[1]); w.y = cvt_pk_bf16(v0[2], v0[3]); w.z = cvt_pk_bf16(v1[0], v1[1]); w.w = cvt_pk_bf16(v1[2], v1[3]);
                        *(u32x4*)(rowp + bj * HALF) = w; } }
        } else {
            bf16_t* Rr = (bf16_t*)d.P1; bf16_t* Gp = Rr + (size_t)T * D; const float* bias = (const float*)d.P2;
            const int dc0 = (u.col0 >> 1) + wc * 32 + 8 * fq;
            f32x4 bf[2], bp[2];
#pragma unroll
            for (int bj = 0; bj < 2; ++bj) { bf[bj] = *(const f32x4*)(bias + dc0 + 4 * bj); bp[bj] = *(const f32x4*)(bias + D + dc0 + 4 * bj); }
#pragma unroll
            for (int ai = 0; ai < 2; ++ai)
#pragma unroll
                for (int m = 0; m < 4; ++m) { const size_t off = (size_t)(rowb + ai * HALF + m * 16) * D + dc0; float rr[8], gg[8];
#pragma unroll
                    for (int bj = 0; bj < 2; ++bj) { const f32x4 av = acc[ai][bj][m][0] + bf[bj], bv = acc[ai][bj][m][1] + bp[bj];
#pragma unroll
                        for (int j = 0; j < 4; ++j) { const float ea = __builtin_amdgcn_exp2f(-1.4426950408889634f * fmaxf(av[j], -30.f)), eb = __builtin_amdgcn_exp2f(-1.4426950408889634f * fmaxf(bv[j], -30.f));
                            gg[4 * bj + j] = __builtin_amdgcn_rcpf(1.0f + eb); rr[4 * bj + j] = (1.0f + eb) * __builtin_amdgcn_rcpf(1.0f + ea); } }
                    u32x4 w; w.x = cvt_pk_bf16(rr[0], rr[1]); w.y = cvt_pk_bf16(rr[2], rr[3]); w.z = cvt_pk_bf16(rr[4], rr[5]); w.w = cvt_pk_bf16(rr[6], rr[7]);
                    *(u32x4*)(Rr + off) = w;
                    u32x4 g; g.x = cvt_pk_bf16(gg[0], gg[1]); g.y = cvt_pk_bf16(gg[2], gg[3]); g.z = cvt_pk_bf16(gg[4], gg[5]); g.w = cvt_pk_bf16(gg[6], gg[7]);
                    *(u32x4*)(Gp + off) = g; }
        }
    } else if (d.mode == EPI_GATED) {
        bf16_t* O = (bf16_t*)d.O; const bf16_t* Gm = (const bf16_t*)d.P1; const int col0 = u.col0 + wc * 32 + 8 * fq;
#pragma unroll
        for (int ai = 0; ai < 2; ++ai) { u32x4 g[4][2];
#pragma unroll
            for (int m = 0; m < 4; ++m)
#pragma unroll
                for (int bj = 0; bj < 2; ++bj) g[m][bj] = *(const u32x4*)(Gm + (size_t)(rowb + ai * HALF + m * 16) * D + col0 + bj * HALF);
#pragma unroll
            for (int m = 0; m < 4; ++m) { const size_t r = (size_t)(rowb + ai * HALF + m * 16);
#pragma unroll
                for (int bj = 0; bj < 2; ++bj) { const f32x4 v0 = acc[ai][bj][m][0], v1 = acc[ai][bj][m][1]; const u32x4 q = g[m][bj];
                    u32x4 w; w.x = cvt_pk_bf16(v0[0] * bf_lo(q.x), v0[1] * bf_hi(q.x)); w.y = cvt_pk_bf16(v0[2] * bf_lo(q.y), v0[3] * bf_hi(q.y));
                    w.z = cvt_pk_bf16(v1[0] * bf_lo(q.z), v1[1] * bf_hi(q.z)); w.w = cvt_pk_bf16(v1[2] * bf_lo(q.w), v1[3] * bf_hi(q.w));
                    *(u32x4*)(O + r * D + col0 + bj * HALF) = w; } }
            asm volatile("" ::: "memory"); }
    } else if (d.mode == EPI_SWIGLU) {
        unsigned char* O = (unsigned char*)d.O; const int hc0 = (u.col0 >> 1) + wc * 16 + 4 * fq;
#pragma unroll
        for (int ai = 0; ai < 2; ++ai)
#pragma unroll
            for (int m = 0; m < 4; ++m) { unsigned char* rowp = O + (size_t)(rowb + ai * HALF + m * 16) * HP + hc0;
#pragma unroll
                for (int bj = 0; bj < 2; ++bj) { const f32x4 g = acc[ai][bj][m][0], up = acc[ai][bj][m][1]; float h[4];
#pragma unroll
                    for (int j = 0; j < 4; ++j) h[j] = g[j] * sigmoidf_fast(g[j]) * up[j];
                    int w = 0; w = __builtin_amdgcn_cvt_pk_fp8_f32(h[0], h[1], w, false); w = __builtin_amdgcn_cvt_pk_fp8_f32(h[2], h[3], w, true);
                    *(int*)(rowp + bj * 64) = w; } }
    } else {
        bf16_t* O = (bf16_t*)d.O; const float* gs = (const float*)d.P1; const int col0 = u.col0 + wc * 32 + 8 * fq;
#pragma unroll
        for (int ai = 0; ai < 2; ++ai)
#pragma unroll
            for (int m = 0; m < 4; ++m) { const size_t r = (size_t)(rowb + ai * HALF + m * 16); const float s = gs[r]; bf16_t* rowp = O + r * D + col0;
#pragma unroll
                for (int bj = 0; bj < 2; ++bj) { const f32x4 v0 = acc[ai][bj][m][0] * s, v1 = acc[ai][bj][m][1] * s;
                    u32x4 w; w.x = cvt_pk_bf16(v0[0], v0[1]); w.y = cvt_pk_bf16(v0[2], v0[3]); w.z = cvt_pk_bf16(v1[0], v1[1]); w.w = cvt_pk_bf16(v1[2], v1[3]);
                    *(u32x4*)(rowp + bj * HALF) = w; } }
    }
}

__device__ __forceinline__ void midk_scale(const GemmDesc& d, f32x4 (&acc)[2][2][4][2], const Unit& u, int wr, int wc, int fr, int fq) {
    typedef __attribute__((address_space(1))) const bf16_t* gptr;
    gptr p0 = (gptr)((const bf16_t*)d.P2 + (size_t)(u.row0 + wr * 64 + fr) * D + (u.col0 + wc * 32 + 8 * fq));
    asm volatile("" : "+v"(p0));
#pragma unroll
    for (int ai = 0; ai < 2; ++ai) { u32x4 g[4][2];
#pragma unroll
        for (int m = 0; m < 4; ++m)
#pragma unroll
            for (int bj = 0; bj < 2; ++bj) g[m][bj] = *(const __attribute__((address_space(1))) u32x4*)(p0 + (size_t)(ai * HALF + m * 16) * D + bj * HALF);
#pragma unroll
        for (int m = 0; m < 4; ++m)
#pragma unroll
            for (int bj = 0; bj < 2; ++bj) { const u32x4 q = g[m][bj]; f32x4& v0 = acc[ai][bj][m][0]; f32x4& v1 = acc[ai][bj][m][1];
                v0[0] *= bf_lo(q.x); v0[1] *= bf_hi(q.x); v0[2] *= bf_lo(q.y); v0[3] *= bf_hi(q.y); v1[0] *= bf_lo(q.z); v1[1] *= bf_hi(q.z); v1[2] *= bf_lo(q.w); v1[3] *= bf_hi(q.w); }
        asm volatile("" ::: "memory"); }
}

__device__ __forceinline__ void tile_prefetch(const void* base, int row0, int col0, LAS unsigned char* lds, int tid, int wid) {
    const char* p = (const char*)base + ((size_t)(row0 + (tid >> 1)) * D + col0) * 2 + (tid & 1) * 256;
    asm volatile("" : "+v"(p));
    LAS unsigned* dst = (LAS unsigned*)(lds + 131072 + wid * 512);
    __builtin_amdgcn_global_load_lds((const unsigned*)p, dst, 4, 0, 0);
    __builtin_amdgcn_global_load_lds((const unsigned*)(p + 128), dst + 64, 4, 0, 0);
}

template <bool GATHER, bool HOOK, bool FP8>
__device__ __forceinline__ void gemm_run(LAS unsigned char* lds, const GemmDesc& d, int G, int cblk, const int tid) {
    const int wid = __builtin_amdgcn_readfirstlane(tid >> 6), lane = tid & 63, wr = wid >> 2, wc = wid & 3, fr = lane & 15, fq = lane >> 4;
    const int nt = d.K / BK; const int c = cblk - d.coff;
    unsigned voffA[2], voffB[2];
#pragma unroll
    for (int i = 0; i < 2; ++i) { int R, C; stage_rc(tid * 16 + i * 8192, R, C); const int Rb = d.perm ? ((R & ~31) + perm32(R & 31)) : R;
        voffA[i] = (unsigned)(R * d.lda + C) * 2u; voffB[i] = (unsigned)(Rb * d.ldb + C) * 2u; }
    const unsigned kstep = BK * 2;
    const unsigned hstepA = (unsigned)HALF * d.lda * 2, hstepB = (unsigned)HALF * d.ldb * 2;
    const unsigned ldsw = (unsigned)wid * 1024u;
    const int aoff = lds_byte(wr * 64 + fr, fq * 8), boff = lds_byte(wc * 32 + fr, fq * 8);
#define PG8_SA(b, h) (((b) * 2 + (h)) * HTB)
#define PG8_SB(b, h) ((4 + (b) * 2 + (h)) * HTB)
#define PG8_LDA(dst, b, h) do { _Pragma("unroll") for (int m = 0; m < 4; ++m) _Pragma("unroll") for (int k = 0; k < 2; ++k) dst[m][k] = *(const LAS bf16x8*)(lds + PG8_SA(b, h) + aoff + m * 2048 + k * 1024); } while (0)
#define PG8_LDB(dst, b, h) do { _Pragma("unroll") for (int n = 0; n < 2; ++n) _Pragma("unroll") for (int k = 0; k < 2; ++k) dst[n][k] = *(const LAS bf16x8*)(lds + PG8_SB(b, h) + boff + n * 2048 + k * 1024); } while (0)
    int fscale = 124; asm volatile("" : "+v"(fscale));
#define PG8_MMA(ai, bj, At, Bt) do { __builtin_amdgcn_s_setprio(1); _Pragma("unroll") for (int m = 0; m < 4; ++m) _Pragma("unroll") for (int n = 0; n < 2; ++n) { \
        if constexpr (FP8) { const i32x8 b8_ = __builtin_shufflevector(__builtin_bit_cast(i32x4, Bt[n][0]), __builtin_bit_cast(i32x4, Bt[n][1]), 0, 1, 2, 3, 4, 5, 6, 7), \
                a8_ = __builtin_shufflevector(__builtin_bit_cast(i32x4, At[m][0]), __builtin_bit_cast(i32x4, At[m][1]), 0, 1, 2, 3, 4, 5, 6, 7); \
            asm volatile("v_mfma_scale_f32_16x16x128_f8f6f4 %0, %1, %2, %0, %3, %3 op_sel_hi:[0,0,0]" : "+v"(acc[ai][bj][m][n]) : "v"(b8_), "v"(a8_), "v"(fscale)); } \
        else { _Pragma("unroll") for (int k = 0; k < 2; ++k) acc[ai][bj][m][n] = __builtin_amdgcn_mfma_f32_16x16x32_bf16(Bt[n][k], At[m][k], acc[ai][bj][m][n], 0, 0, 0); } } \
        __builtin_amdgcn_s_setprio(0); } while (0)
#define PG8_WAIT_V(n) asm volatile("s_waitcnt vmcnt(" #n ")" ::: "memory")
#define PG8_WAIT_L(n) asm volatile("s_waitcnt lgkmcnt(" #n ")" ::: "memory")
#define PG8_BAR __builtin_amdgcn_s_barrier()
#define PG8_SCHED __builtin_amdgcn_sched_barrier(0)
    const unsigned stash = 131072u + (unsigned)tid * 32u; int cs = 0;
#define PG8_GATHER_OFFS(slot_, row0_) do { int gi_[2][2]; \
        _Pragma("unroll") for (int h_ = 0; h_ < 2; ++h_) _Pragma("unroll") for (int i_ = 0; i_ < 2; ++i_) { int R_, C_; stage_rc(tid * 16 + i_ * 8192, R_, C_); gi_[h_][i_] = ((const int*)d.gidx)[(row0_) + h_ * HALF + R_]; } \
        asm volatile("s_waitcnt vmcnt(0)" ::: "memory"); u32x4 o_; \
        { int R_, C_; stage_rc(tid * 16, R_, C_); o_.x = (unsigned)(gi_[0][0] * d.lda + C_) * 2u; o_.z = (unsigned)(gi_[1][0] * d.lda + C_) * 2u; } \
        { int R_, C_; stage_rc(tid * 16 + 8192, R_, C_); o_.y = (unsigned)(gi_[0][1] * d.lda + C_) * 2u; o_.w = (unsigned)(gi_[1][1] * d.lda + C_) * 2u; } \
        *(LAS u32x4*)(lds + stash + (slot_) * 16) = o_; } while (0)
#define PG8_STAGE(bufoff, rsrc, soff, voff) do { _Pragma("unroll") for (int _i = 0; _i < 2; ++_i) \
        __builtin_amdgcn_raw_ptr_buffer_load_lds(rsrc, (LAS unsigned*)(lds + (bufoff) + ldsw + _i * 8192), 16, (voff)[_i], (soff), 0, 0); } while (0)
#define PG8_STAGE_G(bufoff, soff, slot_, h_) do { const u32x2 o_ = *(const LAS u32x2*)(lds + stash + (slot_) * 16 + (h_) * 8); \
        __builtin_amdgcn_raw_ptr_buffer_load_lds(rsrcA, (LAS unsigned*)(lds + (bufoff) + ldsw), 16, o_.x, (soff), 0, 0); \
        __builtin_amdgcn_raw_ptr_buffer_load_lds(rsrcA, (LAS unsigned*)(lds + (bufoff) + ldsw + 8192), 16, o_.y, (soff), 0, 0); } while (0)
#define PG8_STAGE_A(bufoff, soff, slot_, h_) do { if constexpr (GATHER) PG8_STAGE_G(bufoff, soff, slot_, h_); else PG8_STAGE(bufoff, rsrcA, (soff) + (h_) * hstepA, voffA); } while (0)
#define PG8_STAGE_B(bufoff, soff) PG8_STAGE(bufoff, rsrcB, soff, voffB)
    const __amdgpu_buffer_rsrc_t rsrcA = __builtin_amdgcn_make_buffer_rsrc((void*)d.A, 0, 0x7fffffff, 0x00020000), rsrcB = __builtin_amdgcn_make_buffer_rsrc((void*)d.B, 0, 0x7fffffff, 0x00020000);
    Unit cur, nxt; int ui = 0;
    if (!unit_next(d, 0, G, c, cur)) return;
    f32x4 acc[2][2][4][2];
#pragma unroll
    for (int a = 0; a < 2; ++a)
#pragma unroll
        for (int b = 0; b < 2; ++b)
#pragma unroll
            for (int m = 0; m < 4; ++m)
#pragma unroll
                for (int n = 0; n < 2; ++n) acc[a][b][m][n] = (f32x4){0.f, 0.f, 0.f, 0.f};
    bf16x8 At[4][2], B0[2][2], B1[2][2];
    unsigned cA = cur.A, cB = cur.B;
    if constexpr (GATHER) PG8_GATHER_OFFS(cs, cur.row0);
    PG8_STAGE_B(PG8_SB(0, 0), cB); PG8_STAGE_B(PG8_SB(0, 1), cB + hstepB); PG8_STAGE_A(PG8_SA(0, 0), cA, cs, 0); PG8_STAGE_A(PG8_SA(0, 1), cA, cs, 1);
    if (wr == 1) PG8_BAR;
    PG8_WAIT_V(2); PG8_BAR;
    PG8_STAGE_B(PG8_SB(1, 0), cB + kstep); PG8_STAGE_A(PG8_SA(1, 0), cA + kstep, cs, 0); PG8_STAGE_B(PG8_SB(1, 1), cB + hstepB + kstep);
    PG8_WAIT_V(6); PG8_BAR;
    for (;;) {
        const bool has_next = unit_next(d, ui + 1, G, c, nxt);
        const unsigned nA = has_next ? nxt.A : cA, nB = has_next ? nxt.B : cB;
        if constexpr (HOOK) { if (d.hook_t >= 0) tile_prefetch(d.P2, cur.row0, cur.col0, lds, tid, wid); }
        if constexpr (GATHER) { if (has_next) PG8_GATHER_OFFS(cs ^ 1, nxt.row0); else { const u32x4 o_ = *(const LAS u32x4*)(lds + stash + cs * 16); *(LAS u32x4*)(lds + stash + (cs ^ 1) * 16) = o_; } }
        for (int t = 0; t < nt; t += 2) {
            const bool last = (t == nt - 2);
            const unsigned a1 = cA + (unsigned)(t + 1) * kstep;
            const unsigned a2 = last ? nA : cA + (unsigned)(t + 2) * kstep, b2 = last ? nB : cB + (unsigned)(t + 2) * kstep;
            const unsigned a3 = a2 + kstep, b3 = b2 + kstep;
            const int ns = last ? (cs ^ 1) : cs;
            if constexpr (HOOK) { if (d.hook_t == t) { midk_scale(d, acc, cur, wr, wc, fr, fq); tile_prefetch(d.P1, cur.row0, cur.col0, lds, tid, wid); } }
            PG8_LDB(B0, 0, 0); PG8_LDB(B1, 0, 1); PG8_SCHED; PG8_LDA(At, 0, 0); PG8_STAGE_A(PG8_SA(1, 1), a1, cs, 1);
            PG8_WAIT_V(8); PG8_WAIT_L(0); PG8_BAR; PG8_MMA(0, 0, At, B0); PG8_MMA(0, 1, At, B1); PG8_BAR; PG8_SCHED;
            PG8_LDA(At, 0, 1); PG8_STAGE_B(PG8_SB(0, 0), b2); PG8_STAGE_B(PG8_SB(0, 1), b2 + hstepB); PG8_STAGE_A(PG8_SA(0, 0), a2, ns, 0);
            PG8_WAIT_V(8); PG8_WAIT_L(0); PG8_BAR; PG8_MMA(1, 0, At, B0); PG8_MMA(1, 1, At, B1); PG8_BAR; PG8_SCHED;
            PG8_LDB(B0, 1, 0); PG8_LDB(B1, 1, 1); PG8_SCHED; PG8_LDA(At, 1, 0); PG8_STAGE_A(PG8_SA(0, 1), a2, ns, 1);
            PG8_WAIT_V(8); PG8_WAIT_L(0); PG8_BAR; PG8_MMA(0, 0, At, B0); PG8_MMA(0, 1, At, B1); PG8_BAR; PG8_SCHED;
            PG8_LDA(At, 1, 1); PG8_STAGE_B(PG8_SB(1, 0), b3); PG8_STAGE_B(PG8_SB(1, 1), b3 + hstepB); PG8_STAGE_A(PG8_SA(1, 0), a3, ns, 0);
            PG8_WAIT_V(8); PG8_WAIT_L(0); PG8_BAR; PG8_MMA(1, 0, At, B0); PG8_MMA(1, 1, At, B1); PG8_BAR; PG8_SCHED;
        }
        if (wr == 0) PG8_BAR;
        if constexpr (FP8) asm volatile("s_nop 15\n\ts_nop 15" ::: "memory");
        epilogue(d, acc, cur, wr, wc, fr, fq);
        if (!has_next) break;
#pragma unroll
        for (int a = 0; a < 2; ++a)
#pragma unroll
            for (int b = 0; b < 2; ++b)
#pragma unroll
                for (int m = 0; m < 4; ++m)
#pragma unroll
                    for (int n = 0; n < 2; ++n) acc[a][b][m][n] = (f32x4){0.f, 0.f, 0.f, 0.f};
        cur = nxt; cA = nA; cB = nB; ++ui;
        if constexpr (GATHER) cs ^= 1;
        if (wr == 1) PG8_BAR;
    }
    PG8_WAIT_V(0);
    PG8_BAR;
#undef PG8_SA
#undef PG8_SB
#undef PG8_STAGE
#undef PG8_LDA
#undef PG8_LDB
#undef PG8_MMA
#undef PG8_WAIT_V
#undef PG8_WAIT_L
#undef PG8_BAR
#undef PG8_SCHED
#undef PG8_GATHER_OFFS
#undef PG8_STAGE_G
#undef PG8_STAGE_A
#undef PG8_STAGE_B
}

struct Args { const float* in[17]; float* out; unsigned char* ws; int ph_lo, ph_hi; };
enum In { I_X = 0, I_NMIX, I_WIN, I_WFM, I_WPM, I_PSCALE, I_WBF, I_WBP, I_WGATE, I_BGATE, I_WOUT, I_NMOE, I_WROUTER, I_WEG, I_WEU, I_WED, I_NFINAL };

enum GemmId { G_MGU = 0, G_MGV, G_MGP, G_1A, G_1B, G_1C, G_DFTU, G_DFTV, G_4, G_OUT, G_GU, G_DOWN };
__device__ __forceinline__ void make_desc(int id, const Args& a, GemmDesc& d) {
    unsigned char* ws = a.ws;
    d.sAz = 0; d.sBz = 0; d.rz = 0; d.rm = BM; d.nZ = 1; d.coff = 0; d.oz = 0; d.P1 = nullptr; d.P2 = nullptr; d.perm = 1; d.mode = EPI_STORE; d.hook_t = -1; d.gidx = nullptr;
    switch (id) {
    case G_MGU:
    case G_MGV:
    case G_MGP:
        d.A = (const char*)(ws + (id == G_MGP ? WS_WBPT : WS_WBFT)); d.lda = FW; d.B = (const char*)(ws + (id == G_MGU ? WS_MIXC : id == G_MGV ? WS_MIXS : WS_MIXP)); d.ldb = 256; d.K = 256; d.nM = 8; d.nN = 1; d.nZ = 4;
        d.sAz = 256 * 2; d.sAm = (long)BM * FW * 2; d.sBz = 256 * 256 * 2; d.sBn = 0; d.O = ws + WS_WUVP + (size_t)(id - G_MGU) * FW * 2; d.ldc = UVZ; d.oz = 256; d.coff = 32 * (id - G_MGU); break;
    case G_1A:
        d.A = (const char*)(ws + WS_WTIN); d.lda = D; d.B = (const char*)(ws + WS_RA); d.ldb = D; d.K = D; d.nM = 4; d.nN = 8; d.nZ = 8;
        d.sAm = (long)BM * D * 2; d.sBz = (long)SEQ * D * 2; d.sBn = (long)BM * D * 2; d.O = ws + WS_RB; d.ldc = SEQ; d.oz = (long)FW * SEQ; break;
    case G_1B:
        d.A = (const char*)(ws + WS_RA); d.lda = D; d.B = (const char*)(ws + WS_WTIN + (size_t)FW * D * 2); d.ldb = D; d.K = D; d.nM = T / BM; d.nN = 4;
        d.sAm = (long)BM * D * 2; d.sBn = (long)BM * D * 2; d.mode = EPI_PG; d.perm = 1; d.O = ws + WS_RC; d.ldc = FW; d.P1 = ws + WS_RD; d.P2 = a.in[I_BGATE]; break;
    case G_1C:
        d.A = (const char*)(ws + WS_RE); d.lda = D / 2; d.B = (const char*)(ws + WS_WTG); d.ldb = D / 2; d.K = D / 2; d.nM = T / BM; d.nN = 16;
        d.sAm = (long)BM * D; d.sBn = (long)BM * D; d.mode = EPI_PG; d.perm = 0; d.O = ws + WS_RC; d.ldc = FW; d.P1 = ws + WS_RD; d.P2 = a.in[I_BGATE]; break;
    case G_DFTU:
    case G_DFTV:
        { const int ku = (id == G_DFTU ? KU : FW);
        d.A = (const char*)(ws + (id == G_DFTU ? WS_TC : WS_TS)); d.lda = ku; d.B = (const char*)(ws + (id == G_DFTU ? WS_PP : WS_PM)); d.ldb = ku; d.K = ku; d.nM = 4; d.nN = 4; d.nZ = 8;
        d.sAm = (long)BM * ku * 2; d.sBz = (long)FW * ku * 2; d.sBn = (long)BM * ku * 2; d.rz = SEQ; d.mode = EPI_MIRROR; d.O = ws + WS_RE + (id == G_DFTV ? FW * 2 : 0); d.ldc = UVZ; d.oz = (id == G_DFTV); d.coff = (id == G_DFTV ? 128 : 0); }
        break;
    case G_4:
        d.A = (const char*)(ws + WS_RE); d.lda = UVZ; d.B = (const char*)(ws + WS_WUVP); d.ldb = UVZ; d.K = UVZ; d.nM = T / BM; d.nN = 8;
        d.sAm = (long)BM * UVZ * 2; d.sBn = (long)BM * UVZ * 2; d.mode = EPI_GATED; d.O = ws + WS_RA; d.ldc = D; d.hook_t = (2 * FW / BK);
        d.P1 = ws + WS_RD + (size_t)T * D * 2; d.P2 = ws + WS_RD; break;
    case G_OUT:
        d.A = (const char*)(ws + WS_RA); d.lda = D; d.B = (const char*)(ws + WS_WOUT); d.ldb = D; d.K = D; d.nM = T / BM; d.nN = 8;
        d.sAm = (long)BM * D * 2; d.sBn = (long)BM * D * 2; d.mode = EPI_STORE; d.O = a.out; d.ldc = 2 * D; break;
    case G_GU:
        d.A = (const char*)(ws + WS_RA); d.lda = D / 2; d.B = (const char*)(ws + WS_WGU); d.ldb = D / 2; d.K = D / 2; d.nM = BATCH; d.nN = 11; d.nZ = NE;
        d.sAz = 0; d.sAm = (long)SEQ * D; d.sBz = (long)2 * FF * D; d.sBn = (long)BM * D; d.rz = BM; d.rm = NE * BM;
        d.mode = EPI_SWIGLU; d.perm = 0; d.O = ws + WS_RB; d.ldc = FF; d.gidx = ws + WS_IDX; break;
    default:
        d.A = (const char*)(ws + WS_RB); d.lda = HP / 2; d.B = (const char*)(ws + WS_WD); d.ldb = HP / 2; d.K = HP / 2; d.nM = BATCH; d.nN = 8; d.nZ = NE;
        d.sAz = (long)BM * HP; d.sAm = (long)NE * BM * HP; d.sBz = (long)D * HP; d.sBn = (long)BM * HP; d.rz = BM; d.rm = NE * BM;
        d.mode = EPI_ROWSCALE; d.O = ws + WS_RD; d.ldc = D; d.P1 = ws + WS_GATE; break;
    }
}

__device__ __forceinline__ void transpose_tile(const float* src, int ldw, bf16_t* dbase, int ldt, int il, LAS float* scr, int lane) {
    f32x4 v[16];
#pragma unroll
    for (int j = 0; j < 16; ++j) v[j] = *(const f32x4*)(src + (size_t)(4 * j + (lane >> 4)) * ldw + 4 * (lane & 15));
#pragma unroll
    for (int j = 0; j < 16; ++j) *(LAS f32x4*)(scr + (4 * j + (lane >> 4)) * 68 + 4 * (lane & 15)) = v[j];
    LDS_WAIT(); asm volatile("" ::: "memory");
    const int c = lane & 7;
#pragma unroll
    for (int jj = 0; jj < 8; ++jj) { const int n = (lane >> 3) + 8 * jj; const LAS float* s = scr + (8 * c) * 68 + n;
        u32x4 o; o.x = cvt_pk_bf16(s[0 * 68], s[1 * 68]); o.y = cvt_pk_bf16(s[2 * 68], s[3 * 68]); o.z = cvt_pk_bf16(s[4 * 68], s[5 * 68]); o.w = cvt_pk_bf16(s[6 * 68], s[7 * 68]);
        const int ro = il == 1 ? ((n >> 4) * 32 + (n & 15)) : il == 2 ? (128 * ((n >> 2) & 1) + 32 * (n >> 5) + 4 * ((n >> 3) & 3) + (n & 3)) : n;
        *(u32x4*)(dbase + (size_t)ro * ldt + 8 * c) = o; }
    LDS_WAIT(); asm volatile("" ::: "memory");
}

__device__ __forceinline__ void transpose_tile_f8(const float* src, int ldw, unsigned char* dmat, int ldt, int n0, int il, int up16, float scale, LAS float* scr, int lane) {
    f32x4 v[16];
#pragma unroll
    for (int j = 0; j < 16; ++j) v[j] = *(const f32x4*)(src + (size_t)(8 * j + (lane >> 3)) * ldw + 4 * (lane & 7));
#pragma unroll
    for (int j = 0; j < 16; ++j) { const int k = 8 * j + (lane >> 3); *(LAS f32x4*)(scr + k * 32 + ((4 * (lane & 7) + 8 * (k >> 4)) & 31)) = v[j] * scale; }
    LDS_WAIT(); asm volatile("" ::: "memory");
    const int c = lane >> 3;
#pragma unroll
    for (int jj = 0; jj < 4; ++jj) { const int n = (lane & 7) + 8 * jj; const LAS float* s = scr + (16 * c) * 32 + ((n + 8 * c) & 31); i32x4 o;
#pragma unroll
        for (int q = 0; q < 4; ++q) { int w = 0; w = __builtin_amdgcn_cvt_pk_fp8_f32(s[(4 * q) * 32], s[(4 * q + 1) * 32], w, false); w = __builtin_amdgcn_cvt_pk_fp8_f32(s[(4 * q + 2) * 32], s[(4 * q + 3) * 32], w, true); o[q] = w; }
        const int hn = n0 + n; const int dd_ = hn & 127;
        const int ro = il == 1 ? ((hn >> 7) * 256 + ((hn >> 6) & 1) * 128 + ((hn >> 4) & 3) * 32 + (hn & 15) + up16)
                     : il == 2 ? (((hn & 2047) >> 7) * 256 + 128 * ((dd_ >> 2) & 1) + 32 * (dd_ >> 5) + 16 * (hn >> 11) + 4 * ((dd_ >> 3) & 3) + (dd_ & 3)) : hn;
        *(i32x4*)(dmat + (size_t)ro * ldt + 16 * c) = o; }
    LDS_WAIT(); asm volatile("" ::: "memory");
}

__device__ __forceinline__ void p0_items(const Args& a, LAS unsigned char* lds, int gw, int NGW, int wave, int lane, int it_lo, int it_hi) {
    unsigned char* ws = a.ws;
    LAS float* scr = (LAS float*)(lds + wave * (64 * 68 * 4));
    constexpr int I0 = 1024, I1 = 2048, I2 = 512, I3 = 512, I4 = 1024, IE = 16 * 704;
    constexpr int NITEMS = I0 + I1 + I2 + I3 + I4 + 3 * IE;
    (void)NITEMS;
    for (int it = it_lo + gw; it < it_hi; it += NGW) {
        int r = it; const float* src; int ldw, ldt, il = 0; bf16_t* db;
        if (r < I0) { const int kb = r / 32, nb = r % 32; src = a.in[I_WIN] + (size_t)(64 * kb) * D + 64 * nb; ldw = D; ldt = D; db = (bf16_t*)(ws + WS_WTIN) + (size_t)(64 * nb) * D + 64 * kb; }
        else if ((r -= I0) < I1) { const int kb = r / 128, nb = r % 128;
            transpose_tile_f8(a.in[I_WGATE] + (size_t)(128 * kb) * (2 * D) + 32 * nb, 2 * D, ws + WS_WTG + 128 * kb, D, 32 * nb, 2, 0, 64.0f, scr, lane); continue; }
        else if ((r -= I1) < I2) { const int kb = r / 32, nb = r % 32; src = a.in[I_WBF] + (size_t)(64 * kb) * D + 64 * nb; ldw = D; ldt = FW; db = (bf16_t*)(ws + WS_WBFT) + (size_t)(64 * nb) * FW + 64 * kb; }
        else if ((r -= I2) < I3) { const int kb = r / 32, nb = r % 32; src = a.in[I_WBP] + (size_t)(64 * kb) * D + 64 * nb; ldw = D; ldt = FW; db = (bf16_t*)(ws + WS_WBPT) + (size_t)(64 * nb) * FW + 64 * kb; }
        else if ((r -= I3) < I4) { const int kb = r / 32, nb = r % 32; src = a.in[I_WOUT] + (size_t)(64 * kb) * D + 64 * nb; ldw = D; ldt = D; db = (bf16_t*)(ws + WS_WOUT) + (size_t)(64 * nb) * D + 64 * kb; }
        else if ((r -= I4) < 2 * IE) { const int up = r >= IE; if (up) r -= IE; const int e = r / 704, q = r % 704, kb = q / 44, nb = q % 44;
            src = (up ? a.in[I_WEU] : a.in[I_WEG]) + (size_t)e * D * FF + (size_t)(128 * kb) * FF + 32 * nb;
            transpose_tile_f8(src, FF, ws + WS_WGU + (size_t)e * 2 * FF * D + 128 * kb, D, 32 * nb, 1, 16 * up, 64.0f, scr, lane); continue; }
        else { r -= 2 * IE; const int e = r / 704, q = r % 704, kb = q / 64, nb = q % 64;
            transpose_tile_f8(a.in[I_WED] + (size_t)e * FF * D + (size_t)(128 * kb) * D + 32 * nb, D, ws + WS_WD + (size_t)e * D * HP + 128 * kb, HP, 32 * nb, 0, 0, 64.0f, scr, lane); continue; }
        transpose_tile(src, ldw, db, ldt, il, scr, lane);
    }
}
constexpr int P0_NBASE = 1024 + 2048 + 512 + 512, P0_NITEMS = P0_NBASE + 1024 + 3 * 16 * 704;
__device__ __forceinline__ void p0_prologue(const Args& a, LAS unsigned char* lds, int gw, int NGW, int wave, int lane) {
    unsigned char* ws = a.ws;
    p0_items(a, lds, gw, NGW, wave, lane, 0, P0_NBASE);
    const int gt = gw * 64 + lane, NGT = NGW * 64;
    for (int i = gt; i < FW * 256 / 4; i += NGT) { const f32x4 v = *(const f32x4*)(a.in[I_WPM] + 4 * (size_t)i);
        const int g = i / (256 * 64), c2 = (i % 64) * 4; const f32x4 sc = *(const f32x4*)(a.in[I_PSCALE] + g * 256 + c2);
        u32x2 o; o.x = pk2(v[0] * sc[0], v[1] * sc[1]); o.y = pk2(v[2] * sc[2], v[3] * sc[3]); *(u32x2*)((bf16_t*)(ws + WS_MIXP) + 4 * (size_t)i) = o; }
    { LAS float* ct = (LAS float*)(lds + 147456);
        for (int i = lane + 64 * wave; i < 256; i += 64 * NWAVES) ct[i] = cospif((float)i * (1.0f / 128.0f));
        LDS_WAIT(); __syncthreads();
        for (int i = gt; i < 4 * 256 * 64; i += NGT) { const int c2 = (i & 63) * 4, cp = (i >> 6) & 255, g = i >> 14; const float* w = a.in[I_WFM] + (size_t)g * 65536 + c2;
            f32x4 sc_ = {0.f, 0.f, 0.f, 0.f}, ss_ = {0.f, 0.f, 0.f, 0.f};
#pragma unroll 8
            for (int c = 0; c < 256; ++c) { const f32x4 wv = *(const f32x4*)(w + (size_t)c * 256); const int ph = (c * cp) & 255; sc_ += wv * ct[ph]; ss_ += wv * ct[(ph - 64) & 255]; }
            const size_t o = (size_t)g * 65536 + (size_t)cp * 256 + c2;
            u32x2 oc; oc.x = pk2(sc_[0] * 0.0625f, sc_[1] * 0.0625f); oc.y = pk2(sc_[2] * 0.0625f, sc_[3] * 0.0625f); *(u32x2*)((bf16_t*)(ws + WS_MIXC) + o) = oc;
            u32x2 os; os.x = pk2(-ss_[0] * 0.0625f, -ss_[1] * 0.0625f); os.y = pk2(-ss_[2] * 0.0625f, -ss_[3] * 0.0625f); *(u32x2*)((bf16_t*)(ws + WS_MIXS) + o) = os; } }
    for (int i = gt; i < NE * D * 8; i += NGT) *(i32x4*)(ws + WS_WD + (size_t)(i >> 3) * HP + FF + 16 * (i & 7)) = (i32x4){0, 0, 0, 0};
    for (int i = gt; i < FW * KU / 2; i += NGT) { const int k = i / (KU / 2), n = (i % (KU / 2)) * 2; float o2[2];
#pragma unroll
        for (int q = 0; q < 2; ++q) { const int ph = (k * (n + q)) & (SEQ - 1); o2[q] = (n + q <= FW) ? cospif((float)ph * (1.0f / 1024.0f)) * 0.02209708691207961f : 0.f; }
        *(unsigned*)((bf16_t*)(ws + WS_TC) + (size_t)k * KU + n) = pk2(o2[0], o2[1]); }
    for (int i = gt; i < FW * FW / 2; i += NGT) { const int k = i / (FW / 2), n = (i % (FW / 2)) * 2; float o2[2];
#pragma unroll
        for (int q = 0; q < 2; ++q) { const int ph = (k * (n + q)) & (SEQ - 1); o2[q] = sinpif((float)ph * (1.0f / 1024.0f)) * 0.02209708691207961f; }
        *(unsigned*)((bf16_t*)(ws + WS_TS) + (size_t)k * FW + n) = pk2(o2[0], o2[1]); }
    const float* gm = a.in[I_NMIX];
    for (int m = gw; m < T; m += NGW) { const f32x4* xr = (const f32x4*)(a.in[I_X] + (size_t)m * D) + lane; f32x4 v[8]; float s = 0.f;
#pragma unroll
        for (int j = 0; j < 8; ++j) { v[j] = xr[64 * j]; s += (v[j][0] * v[j][0] + v[j][1] * v[j][1]) + (v[j][2] * v[j][2] + v[j][3] * v[j][3]); }
        const float rstd = 1.0f / sqrtf(wave_sum(s) * (1.0f / D) + EPS);
        u32x2* o8 = (u32x2*)((bf16_t*)(ws + WS_RA) + (size_t)m * D) + lane; unsigned* o4 = (unsigned*)(ws + WS_RE + (size_t)m * D) + lane;
#pragma unroll
        for (int j = 0; j < 8; ++j) { const f32x4 g = ((const f32x4*)gm)[lane + 64 * j]; const f32x4 uv = v[j] * g * rstd; u32x2 o; o.x = pk2(uv[0], uv[1]); o.y = pk2(uv[2], uv[3]); o8[64 * j] = o;
            int w = 0; w = __builtin_amdgcn_cvt_pk_fp8_f32(uv[0], uv[1], w, false); w = __builtin_amdgcn_cvt_pk_fp8_f32(uv[2], uv[3], w, true); o4[64 * j] = (unsigned)w; } }
}

__device__ __forceinline__ void p3_fold(const Args& a, int gw, int NGW, int lane) {
    const bf16_t* PT = (const bf16_t*)(a.ws + WS_RB); bf16_t* PP = (bf16_t*)(a.ws + WS_PP); bf16_t* PM = (bf16_t*)(a.ws + WS_PM); bf16_t* Z = (bf16_t*)(a.ws + WS_RE);
    for (int row = gw; row < BATCH * FW; row += NGW) { const bf16_t* p = PT + (size_t)row * SEQ; bf16_t* pp = PP + (size_t)row * KU; bf16_t* pm = PM + (size_t)row * FW; float alt = 0.f;
#pragma unroll 4
        for (int i = 0; i < 16; ++i) { const int n = lane + 64 * i; const float x = bf_lo((unsigned)p[n]); const float y = (n > 0) ? bf_lo((unsigned)p[SEQ - n]) : 0.f;
            pp[n] = (bf16_t)f2bf(x + y); pm[n] = (bf16_t)f2bf(n > 0 ? x - y : 0.f); alt += (n & 1) ? -(x + y) : (x + y); }
        const float xm = bf_lo((unsigned)p[FW]);
        if (lane < 64) { const int n = FW + lane; pp[n] = (bf16_t)(lane == 0 ? f2bf(xm) : 0u); pp[n + 64] = 0; }
        alt = wave_sum(alt) + xm;
        if (lane == 0) { const int b = row >> 10, c = row & (FW - 1); Z[(size_t)(b * SEQ + FW) * UVZ + c] = (bf16_t)f2bf(alt * 0.02209708691207961f); Z[(size_t)(b * SEQ + FW) * UVZ + FW + c] = 0; } }
}

__device__ __forceinline__ void ld8(const bf16_t* p, float (&f)[8]) { const u32x4 w = *(const u32x4*)p; f[0] = bf_lo(w.x); f[1] = bf_hi(w.x); f[2] = bf_lo(w.y); f[3] = bf_hi(w.y); f[4] = bf_lo(w.z); f[5] = bf_hi(w.z); f[6] = bf_lo(w.w); f[7] = bf_hi(w.w); }
__device__ __forceinline__ void p3_pool(const Args& a, int gtid, int NGT) {
    const bf16_t* P = (const bf16_t*)(a.ws + WS_RC); bf16_t* Z = (bf16_t*)(a.ws + WS_RE);
    for (int idx = gtid; idx < BATCH * 128 * 128; idx += NGT) {
        const int cb = idx & 127, chunk = (idx >> 7) & 127, b = idx >> 14, half = 1 << (cb >> 5), i0 = chunk * 16;
        const bf16_t* Pb = P + (size_t)b * SEQ * FW + cb * 8;
        float sum[8];
#pragma unroll
        for (int q = 0; q < 8; ++q) sum[q] = 0.f;
        int lo = i0 - half; if (lo < 0) lo = 0; int hi = i0 + half; if (hi > SEQ) hi = SEQ;
        for (int r = lo; r < hi; ++r) { float f[8]; ld8(Pb + (size_t)r * FW, f);
#pragma unroll
            for (int q = 0; q < 8; ++q) sum[q] += f[q]; }
        for (int i = i0; i < i0 + 16; ++i) {
            int l2 = i - half; if (l2 < 0) l2 = 0; int h2 = i + half; if (h2 > SEQ) h2 = SEQ;
            const float inv = 1.0f / (float)(h2 - l2);
            float f[8]; ld8(Pb + (size_t)i * FW, f); float o[8];
#pragma unroll
            for (int q = 0; q < 8; ++q) o[q] = sum[q] * inv - f[q];
            u32x4 w; w.x = pk2(o[0], o[1]); w.y = pk2(o[2], o[3]); w.z = pk2(o[4], o[5]); w.w = pk2(o[6], o[7]);
            *(u32x4*)(Z + (size_t)(b * SEQ + i) * UVZ + 2 * FW + cb * 8) = w;
            if (i + half < SEQ) { float g[8]; ld8(Pb + (size_t)(i + half) * FW, g);
#pragma unroll
                for (int q = 0; q < 8; ++q) sum[q] += g[q]; }
            if (i - half >= 0) { float g[8]; ld8(Pb + (size_t)(i - half) * FW, g);
#pragma unroll
                for (int q = 0; q < 8; ++q) sum[q] -= g[q]; }
        }
    }
}

__device__ __forceinline__ float reduce16(const float (&a)[16], int lane) {
    float b8[8], b4[4], b2[2];
    { const bool hi = lane & 32;
#pragma unroll
      for (int i = 0; i < 8; ++i) { const float snd = hi ? a[i] : a[i + 8], kp = hi ? a[i + 8] : a[i]; b8[i] = kp + __shfl_xor(snd, 32); } }
    { const bool hi = lane & 16;
#pragma unroll
      for (int i = 0; i < 4; ++i) { const float snd = hi ? b8[i] : b8[i + 4], kp = hi ? b8[i + 4] : b8[i]; b4[i] = kp + __shfl_xor(snd, 16); } }
    { const bool hi = lane & 8;
#pragma unroll
      for (int i = 0; i < 2; ++i) { const float snd = hi ? b4[i] : b4[i + 2], kp = hi ? b4[i + 2] : b4[i]; b2[i] = kp + __shfl_xor(snd, 8); } }
    const bool hi = lane & 4; const float snd = hi ? b2[0] : b2[1], kp = hi ? b2[1] : b2[0]; float r = kp + __shfl_xor(snd, 4);
    r += __shfl_xor(r, 2); r += __shfl_xor(r, 1);
    return r;
}
__device__ __forceinline__ void p6_rows(const Args& a, LAS unsigned char* lds, int gw, int NGW, int lane, int tid) {
    LAS float* wt = (LAS float*)lds;
    for (int i = tid; i < D * NE / 4; i += NTHR) { const int dd = i & (D - 1), eq = i >> 11; const f32x4 v = *(const f32x4*)(a.in[I_WROUTER] + (size_t)dd * NE + 4 * eq);
#pragma unroll
        for (int q = 0; q < 4; ++q) wt[(4 * eq + q) * D + dd] = v[q]; }
    LDS_WAIT(); __syncthreads();
    const float* gm = a.in[I_NMOE]; unsigned char* V = (unsigned char*)(a.ws + WS_RA); float* AFF = (float*)(a.ws + WS_AFF);
    for (int i = gw * 64 + lane; i < NPAN * CAP * 8; i += NGW * 64) *(i32x4*)(a.ws + WS_RB + (size_t)(i >> 3) * HP + FF + 16 * (i & 7)) = (i32x4){0, 0, 0, 0};
    const int eL = ((lane >> 5) & 1) * 8 + ((lane >> 4) & 1) * 4 + ((lane >> 3) & 1) * 2 + ((lane >> 2) & 1);
#pragma unroll 1
    for (int m0 = gw; m0 < T; m0 += 2 * NGW) {
        f32x4 v[2][8]; u32x2 dl[2][8];
#pragma unroll
        for (int r = 0; r < 2; ++r) { const int m = min(m0 + r * NGW, T - 1); const f32x4* xr = (const f32x4*)(a.in[I_X] + (size_t)m * D) + lane; const u32x2* dr = (const u32x2*)(a.out + (size_t)m * D) + lane;
#pragma unroll
            for (int j = 0; j < 8; ++j) { v[r][j] = xr[64 * j]; dl[r][j] = dr[64 * j]; } }
#pragma unroll
        for (int r = 0; r < 2; ++r) { float s = 0.f;
#pragma unroll
            for (int j = 0; j < 8; ++j) { const u32x2 w = dl[r][j]; v[r][j][0] += bf_lo(w.x); v[r][j][1] += bf_hi(w.x); v[r][j][2] += bf_lo(w.y); v[r][j][3] += bf_hi(w.y);
                s += (v[r][j][0] * v[r][j][0] + v[r][j][1] * v[r][j][1]) + (v[r][j][2] * v[r][j][2] + v[r][j][3] * v[r][j][3]); }
            const float rstd = 1.0f / sqrtf(wave_sum(s) * (1.0f / D) + EPS);
            const float* gmp = gm; asm volatile("" : "+s"(gmp));
#pragma unroll
            for (int j = 0; j < 8; ++j) { const f32x4 g = ((const f32x4*)gmp)[lane + 64 * j]; v[r][j] = v[r][j] * g * rstd; }
            const int m = m0 + r * NGW;
            if (m < T) { unsigned* o4 = (unsigned*)(V + (size_t)m * D) + lane;
#pragma unroll
                for (int j = 0; j < 8; ++j) { int w = 0; w = __builtin_amdgcn_cvt_pk_fp8_f32(v[r][j][0], v[r][j][1], w, false); w = __builtin_amdgcn_cvt_pk_fp8_f32(v[r][j][2], v[r][j][3], w, true); o4[64 * j] = (unsigned)w; } } }
        float lg0 = 0.f, lg1 = 0.f;
#pragma unroll 1
        for (int e = 0; e < NE; ++e) { float a0 = 0.f, a1 = 0.f; const LAS float* we = wt + e * D + 4 * lane;
#pragma unroll
            for (int j = 0; j < 8; ++j) { const f32x4 w = *(const LAS f32x4*)(we + 256 * j);
                a0 += (v[0][j][0] * w[0] + v[0][j][1] * w[1]) + (v[0][j][2] * w[2] + v[0][j][3] * w[3]); a1 += (v[1][j][0] * w[0] + v[1][j][1] * w[1]) + (v[1][j][2] * w[2] + v[1][j][3] * w[3]); }
            a0 = wave_sum(a0); a1 = wave_sum(a1); if (eL == e) { lg0 = a0; lg1 = a1; } }
#pragma unroll
        for (int r = 0; r < 2; ++r) { const float lg = r ? lg1 : lg0; float mx = lg;
            mx = fmaxf(mx, dpp_mov<0x141>(mx)); mx = fmaxf(mx, dpp_mov<0x140>(mx));
            mx = fmaxf(fmaxf(lane_val(mx, 0), lane_val(mx, 16)), fmaxf(lane_val(mx, 32), lane_val(mx, 48)));
            const float ex = expf(lg - mx); float den = ex;
            den += dpp_mov<0x141>(den); den += dpp_mov<0x140>(den);
            den = (lane_val(den, 0) + lane_val(den, 16)) + (lane_val(den, 32) + lane_val(den, 48));
            const int m = m0 + r * NGW;
            if (m < T && (lane & 3) == 0) AFF[(size_t)m * NE + eL] = ex / den; }
    }
    __syncthreads();
}

__device__ __forceinline__ void p7_topk(const Args& a, LAS unsigned char* lds, int G, const int tid) {
    LAS unsigned* red = (LAS unsigned*)lds;
    const int lane = tid & 63, wave = tid >> 6;
    const float* AFF = (const float*)(a.ws + WS_AFF); int* IDX = (int*)(a.ws + WS_IDX); float* GATE = (float*)(a.ws + WS_GATE); int* INV = (int*)(a.ws + WS_INV);
    for (int p = blockIdx.x; p < NPAN; p += G) {
        const int b = p >> 4, e = p & 15;
        unsigned v[4];
#pragma unroll
        for (int k = 0; k < 4; ++k) v[k] = __builtin_bit_cast(unsigned, AFF[(size_t)(b * SEQ + 4 * tid + k) * NE + e]);
        unsigned prefix = 0u;
        for (int bit = 30; bit >= 0; --bit) {
            const unsigned Tt = prefix | (1u << bit); unsigned c = 0;
#pragma unroll
            for (int k = 0; k < 4; ++k) c += (unsigned)__popcll(__ballot(v[k] >= Tt));
            LAS unsigned* rb = red + (bit & 1) * 8;
            if (lane == 0) rb[wave] = c;
            LDS_WAIT(); __syncthreads();
            unsigned tot = 0;
#pragma unroll
            for (int w = 0; w < 8; ++w) tot += rb[w];
            if (tot >= (unsigned)CAP) prefix = Tt;
        }
        unsigned cg_ = 0, ce_ = 0;
#pragma unroll
        for (int k = 0; k < 4; ++k) { cg_ += v[k] > prefix; ce_ += v[k] == prefix; }
        unsigned sg = cg_, se = ce_;
#pragma unroll
        for (int o = 1; o < 64; o <<= 1) { const unsigned tg = __shfl_up(sg, o), te = __shfl_up(se, o); if (lane >= o) { sg += tg; se += te; } }
        LAS unsigned* sc = red + 64;
        __syncthreads();
        if (lane == 63) { sc[wave] = sg; sc[8 + wave] = se; }
        LDS_WAIT(); __syncthreads();
        unsigned bg = 0, be = 0, totg = 0;
#pragma unroll
        for (int w = 0; w < 8; ++w) { const unsigned xg = sc[w], xe = sc[8 + w]; if (w < wave) { bg += xg; be += xe; } totg += xg; }
        unsigned eg = bg + sg - cg_, ee = be + se - ce_;
        const unsigned need = (unsigned)CAP - totg;
#pragma unroll
        for (int k = 0; k < 4; ++k) { const int n = 4 * tid + k; int slot = -1;
            if (v[k] > prefix) { slot = (int)eg; ++eg; }
            else if (v[k] == prefix) { if (ee < need) slot = (int)(totg + ee); ++ee; }
            if (slot >= 0) { IDX[p * CAP + slot] = n; GATE[p * CAP + slot] = __builtin_bit_cast(float, v[k]); }
            INV[(size_t)(b * SEQ + n) * NE + e] = slot; }
        __syncthreads();
    }
}

__device__ __forceinline__ void p8_gather(const Args& a, int gw, int NGW, int lane) {
    const bf16_t* V = (const bf16_t*)(a.ws + WS_RA); bf16_t* Xs = (bf16_t*)(a.ws + WS_RD); const int* IDX = (const int*)(a.ws + WS_IDX);
    for (int r = gw; r < NPAN * CAP; r += NGW) { const int p = r >> 8, b = p >> 4; const int n = IDX[r];
        const u32x4* src = (const u32x4*)(V + (size_t)(b * SEQ + n) * D) + lane; u32x4* dst = (u32x4*)(Xs + (size_t)r * D) + lane;
        u32x4 t[4];
#pragma unroll
        for (int j = 0; j < 4; ++j) t[j] = src[64 * j];
#pragma unroll
        for (int j = 0; j < 4; ++j) dst[64 * j] = t[j]; }
}

__device__ __forceinline__ void p11_final(const Args& a, int gw, int NGW, int lane, float* dst) {
    float* out = a.out; const bf16_t* Y = (const bf16_t*)(a.ws + WS_RD); const int* INV = (const int*)(a.ws + WS_INV); const float* gf = a.in[I_NFINAL];
    for (int m = gw; m < T; m += NGW) { f32x4* xr = (f32x4*)(dst + (size_t)m * D) + lane; const f32x4* xin = (const f32x4*)(a.in[I_X] + (size_t)m * D) + lane; const u32x2* dr = (const u32x2*)(out + (size_t)m * D) + lane; f32x4 v[8];
#pragma unroll
        for (int j = 0; j < 8; ++j) { v[j] = xin[64 * j]; const u32x2 w = dr[64 * j]; v[j][0] += bf_lo(w.x); v[j][1] += bf_hi(w.x); v[j][2] += bf_lo(w.y); v[j][3] += bf_hi(w.y); }
        const int b = m >> 11;
        i32x4 iv[4];
#pragma unroll
        for (int q = 0; q < 4; ++q) iv[q] = *(const i32x4*)(INV + (size_t)m * NE + 4 * q);
#pragma unroll
        for (int e = 0; e < NE; ++e) { const int slot = __builtin_amdgcn_readfirstlane(iv[e >> 2][e & 3]);
            if (slot >= 0) { const u32x2* yr = (const u32x2*)(Y + ((size_t)(b * NE + e) * CAP + slot) * D) + lane;
#pragma unroll
                for (int j = 0; j < 8; ++j) { const u32x2 w = yr[64 * j]; v[j][0] += bf_lo(w.x); v[j][1] += bf_hi(w.x); v[j][2] += bf_lo(w.y); v[j][3] += bf_hi(w.y); } } }
        float s = 0.f;
#pragma unroll
        for (int j = 0; j < 8; ++j) s += (v[j][0] * v[j][0] + v[j][1] * v[j][1]) + (v[j][2] * v[j][2] + v[j][3] * v[j][3]);
        const float rstd = 1.0f / sqrtf(wave_sum(s) * (1.0f / D) + EPS);
#pragma unroll
        for (int j = 0; j < 8; ++j) { const f32x4 g = ((const f32x4*)gf)[lane + 64 * j]; xr[64 * j] = v[j] * g * rstd; } }
}

#define XB_TMO      128
#define XB_XCNT(j)  (256  + 64 * (j))
#define XB_XSUB(j)  (1280 + 64 * (j))
#define XB_XGEN(j)  (2304 + 64 * (j))
#define XB_TOP      3328
#define XB_TOPGEN   3392
#define XCD_BAR_WORDS 3456
#define XB_SPIN_CAP (1u << 22)
__device__ __forceinline__ unsigned xb_ld(unsigned* p)              { return __hip_atomic_load(p, __ATOMIC_RELAXED, __HIP_MEMORY_SCOPE_AGENT); }
__device__ __forceinline__ unsigned xb_add(unsigned* p, unsigned v) { return __hip_atomic_fetch_add(p, v, __ATOMIC_RELAXED, __HIP_MEMORY_SCOPE_AGENT); }
__device__ __forceinline__ unsigned xb_xcc_id() { return (unsigned)__builtin_amdgcn_s_getreg((3 << 11) | 20) & 0xFu; }
#define XB_SPIN(cond, bar) do { unsigned _sp = 0; while (cond) { __builtin_amdgcn_s_sleep(1); \
    if ((++_sp & 255u) == 0u) { if (xb_ld(&(bar)[XB_TMO])) break; if (_sp > XB_SPIN_CAP) { atomicAdd(&(bar)[XB_TMO], 1u); break; } } } } while (0)
struct XcdBarrier { unsigned* bar; unsigned x; volatile LAS unsigned* st; };
__device__ __forceinline__ XcdBarrier xcd_barrier_post(unsigned* bar, volatile LAS unsigned* st) {
    XcdBarrier b; b.bar = bar; b.x = xb_xcc_id(); b.st = st;
    if (threadIdx.x == 0) (void)xb_add(&bar[XB_XCNT(b.x)], 1u);
    return b;
}
__device__ __forceinline__ void xcd_barrier_complete(unsigned* bar, unsigned x, unsigned& nloc, unsigned& nx) {
    const unsigned G = gridDim.x * gridDim.y * gridDim.z;
    unsigned sum, cnt, mine, sp = 0u;
    for (;;) {
        sum = 0u; cnt = 0u; mine = 0u;
#pragma unroll
        for (unsigned j = 0; j < 16; ++j) { const unsigned c = xb_ld(&bar[XB_XCNT(j)]); sum += c; cnt += (c > 0u) ? 1u : 0u; mine = (j == x) ? c : mine; }
        if (sum == G) break;
        __builtin_amdgcn_s_sleep(1);
        if ((++sp & 255u) == 0u) { if (xb_ld(&bar[XB_TMO])) break; if (sp > XB_SPIN_CAP) { atomicAdd(&bar[XB_TMO], 1u); break; } }
    }
    nloc = mine > 0u ? mine : 1u; nx = cnt > 0u ? cnt : 1u;
}
__device__ __forceinline__ void xcd_barrier(const XcdBarrier& b) {
    asm volatile("s_waitcnt vmcnt(0)" ::: "memory");
    __syncthreads();
    if (threadIdx.x == 0) {
        unsigned* bar = b.bar;
        __builtin_amdgcn_s_waitcnt(0);
        unsigned nloc = b.st[0], nx = b.st[1];
        if (nloc == 0u) { xcd_barrier_complete(bar, b.x, nloc, nx); b.st[0] = nloc; b.st[1] = nx; }
        const unsigned old = xb_add(&bar[XB_XSUB(b.x)], 1u);
        const unsigned gen = old / nloc;
        if (old + 1u == (gen + 1u) * nloc) {
            __builtin_amdgcn_fence(__ATOMIC_RELEASE, "agent");
            asm volatile("s_waitcnt vmcnt(0)" ::: "memory");
            const unsigned og = xb_add(&bar[XB_TOP], 1u);
            const unsigned tg = og / nx;
            if (og + 1u == (tg + 1u) * nx) xb_add(&bar[XB_TOPGEN], 1u);
            else XB_SPIN(xb_ld(&bar[XB_TOPGEN]) == tg, bar);
            __builtin_amdgcn_fence(__ATOMIC_ACQUIRE, "agent");
            xb_add(&bar[XB_XGEN(b.x)], 1u);
            asm volatile("s_waitcnt vmcnt(0)" ::: "memory");
        } else {
            XB_SPIN(xb_ld(&bar[XB_XGEN(b.x)]) == gen, bar);
            __builtin_amdgcn_fence(__ATOMIC_ACQUIRE, "agent");
            asm volatile("s_waitcnt vmcnt(0)" ::: "memory");
        }
    }
    __syncthreads();
}

__global__ void __launch_bounds__(NTHR, 2) fwd_kernel(Args args) {
    extern __shared__ __attribute__((aligned(16))) unsigned char lds_raw[];
    LAS unsigned char* lds = (LAS unsigned char*)lds_raw;
    volatile LAS unsigned* misc = (volatile LAS unsigned*)(lds + MISC_OFF);
    if (threadIdx.x < 64) misc[threadIdx.x] = 0u;
    __syncthreads();
    XcdBarrier xbar = xcd_barrier_post((unsigned*)args.ws, misc);
    const int G = gridDim.x, bx = blockIdx.x;
    const int vcu = (G % 8 == 0) ? (bx % 8) * (G / 8) + bx / 8 : bx;
    constexpr unsigned SEAMS = (1u << 0) | (1u << 7) | (1u << 8) | (1u << 10) | (1u << 11) | (1u << 12) | (1u << 13) | (1u << 14) | (1u << 15) | (1u << 16);
    const int slot = (bx % 8) >> 1;
    for (int pos = args.ph_lo, rep = 0; pos < args.ph_hi; ) {
        int tid = threadIdx.x; asm volatile("" : "+v"(tid));
        int Gs = G; asm volatile("" : "+s"(Gs));
        const int lane = tid & 63, wave = __builtin_amdgcn_readfirstlane(tid >> 6);
        const int gw = vcu * NWAVES + wave, NGW = Gs * NWAVES;
        int step = pos;
        if (pos >= 4 && pos <= 7) { const int q = pos - 4; step = (q == slot) ? 100 : 4 + (q < slot ? q : q - 1); } else if (pos > 7) step = pos - 1;
        int gid = -1;
        switch (step) {
        case 0: p0_prologue(args, lds, gw, NGW, wave, lane); break;
        case 100: p0_items(args, lds, gw, NGW, wave, lane, P0_NBASE, P0_NITEMS); LDS_WAIT(); __syncthreads(); break;
        case 1: gid = G_MGU; break; case 2: gid = G_MGV; break; case 3: gid = G_MGP; break;
        case 4: gid = G_1A; break; case 5: gid = G_1B; break; case 6: gid = G_1C; break;
        case 7: p3_fold(args, gw, NGW, lane); p3_pool(args, gw * 64 + lane, NGW * 64); break;
        case 8: gid = G_DFTU; break; case 9: gid = G_DFTV; break;
        case 10: gid = G_4; break;
        case 11: gid = G_OUT; break;
        case 12: p6_rows(args, lds, gw, NGW, lane, tid); break;
        case 13: p7_topk(args, lds, Gs, tid); break;
        case 14: gid = G_GU; break;
        case 15: gid = G_DOWN; break;
        default: p11_final(args, gw, NGW, lane, args.out); break;
        }
        if (gid >= 0) { GemmDesc d_; make_desc(gid, args, d_); if (gid == G_GU) gemm_run<true, false, true>(lds, d_, Gs, bx, tid); else if (gid == G_DOWN || gid == G_1C) gemm_run<false, false, true>(lds, d_, Gs, bx, tid); else gemm_run<false, true, false>(lds, d_, Gs, bx, tid); }
        if (((PROBE_MASK >> pos) & 1u) && rep == 0) { rep = 1; xcd_barrier(xbar); continue; }
        rep = 0;
        if (((SEAMS >> pos) & 1u) && pos + 1 < args.ph_hi) xcd_barrier(xbar);
        ++pos;
    }
}

extern "C" void kernel_launch(void* const* d_in, const int* in_sizes, int n_in, void* d_out, int out_size, void* d_ws, size_t ws_size, hipStream_t stream) {
    static int grid = 0;
    if (grid == 0) {
        if (n_in != 17 || in_sizes[0] != T * D || out_size != T * D || ws_size < WS_END) { fprintf(stderr, "kernel_launch: unexpected shapes (n_in %d, in0 %d, out %d, ws %zu < %zu); nothing launched\n", n_in, n_in > 0 ? in_sizes[0] : -1, out_size, ws_size, (size_t)WS_END); grid = -1; return; }
        int dev = 0, cus = 0, per_cu = 0;
        if (hipGetDevice(&dev) != hipSuccess || hipDeviceGetAttribute(&cus, hipDeviceAttributeMultiprocessorCount, dev) != hipSuccess) { grid = -1; return; }
        if (hipFuncSetAttribute((const void*)fwd_kernel, hipFuncAttributeMaxDynamicSharedMemorySize, LDS_BYTES) != hipSuccess) { fprintf(stderr, "kernel_launch: hipFuncSetAttribute failed\n"); grid = -1; return; }
        if (hipOccupancyMaxActiveBlocksPerMultiprocessor(&per_cu, (const void*)fwd_kernel, NTHR, LDS_BYTES) != hipSuccess || per_cu < 1) { fprintf(stderr, "kernel_launch: occupancy query failed (%d)\n", per_cu); (void)hipGetLastError(); grid = -1; return; }
        grid = cus * per_cu;
        fprintf(stderr, "kernel_launch: %d CUs x %d per CU = grid %d\n", cus, per_cu, grid);
    }
    if (grid < 0) return;
    if (hipMemsetAsync(d_ws, 0, CTL_ZERO_BYTES, stream) != hipSuccess) { fprintf(stderr, "kernel_launch: hipMemsetAsync failed\n"); return; }
    Args a; memset(&a, 0, sizeof(a));
    for (int i = 0; i < 17; ++i) a.in[i] = (const float*)d_in[i];
    a.out = (float*)d_out; a.ws = (unsigned char*)d_ws;
    if (MK_N_LAUNCHES == 1) {
        a.ph_lo = 0; a.ph_hi = N_STEPS; void* kargs[] = {&a};
        hipError_t e = hipLaunchCooperativeKernel((const void*)fwd_kernel, dim3(grid), dim3(NTHR), kargs, LDS_BYTES, stream);
        if (e != hipSuccess) fprintf(stderr, "kernel_launch: cooperative launch failed: %s (grid %d)\n", hipGetErrorString(e), grid);
    } else {
        static const int cuts[12] = {0, 1, 8, 9, 11, 12, 13, 14, 15, 16, 17, 18};
        for (int p = 0; p < 11; ++p) { a.ph_lo = cuts[p]; a.ph_hi = cuts[p + 1]; void* kargs[] = {&a};
            hipError_t e = hipLaunchCooperativeKernel((const void*)fwd_kernel, dim3(grid), dim3(NTHR), kargs, LDS_BYTES, stream);
            if (e != hipSuccess) { fprintf(stderr, "kernel_launch: launch %d failed: %s (grid %d)\n", p, hipGetErrorString(e), grid); break; } }
    }
}
```

```cpp
#include <hip/hip_runtime.h>
#include <hip/hip_cooperative_groups.h>
#include <cstdio>
#include <cstdint>
#include <cstring>
namespace cg = cooperative_groups;

#define PROBE_MASK 0u
#define PROBE_SEL (-1)
#define PROBE_SEL_END (PROBE_SEL + 1)
#ifndef MK_N_LAUNCHES
#define MK_N_LAUNCHES 1
#endif

#define LAS __attribute__((address_space(3)))
typedef unsigned short bf16_t;
typedef short bf16x8 __attribute__((ext_vector_type(8)));
typedef float f32x4 __attribute__((ext_vector_type(4)));
typedef float f32x2 __attribute__((ext_vector_type(2)));
typedef unsigned u32x4 __attribute__((ext_vector_type(4)));
typedef unsigned u32x2 __attribute__((ext_vector_type(2)));
typedef int i32x4 __attribute__((ext_vector_type(4)));
typedef int i32x8 __attribute__((ext_vector_type(8)));

constexpr int BATCH = 8, SEQ = 2048, D = 2048, T = BATCH * SEQ;
constexpr int NE = 16, FF = 1408, CAP = 256, NPAN = BATCH * NE;
constexpr int FW = 1024;
constexpr int HP = 1536;
constexpr float EPS = 1e-6f;
constexpr float YSC = 16.0f;
constexpr int NWAVES = 8, NTHR = 512;
constexpr int N_STEPS = 18;

constexpr size_t MiB = 1u << 20;
constexpr size_t WS_WTIN = 2 * MiB;
constexpr size_t WS_WTG = 10 * MiB;
constexpr size_t WS_WBFT = 26 * MiB;
constexpr size_t WS_WBPT = 30 * MiB;
constexpr size_t WS_WUVP = 596 * MiB;
constexpr size_t WS_WOUT = 46 * MiB;
constexpr size_t WS_MIXC = 54 * MiB;
constexpr size_t WS_MIXS = 54 * MiB + 512 * 1024;
constexpr size_t WS_MIXP = 55 * MiB;
constexpr size_t WS_TC = 56 * MiB;
constexpr size_t WS_TS = 59 * MiB;
constexpr size_t WS_WGU = 64 * MiB;
constexpr size_t WS_WD = 152 * MiB;
constexpr size_t WS_RA = 200 * MiB;
constexpr size_t WS_RB = 264 * MiB;
constexpr size_t WS_RC = 296 * MiB;
constexpr size_t WS_PP = 328 * MiB;
constexpr size_t WS_PM = 346 * MiB;
constexpr size_t WS_RD = 364 * MiB;
constexpr size_t WS_RE = 492 * MiB;
constexpr size_t WS_AFF = 592 * MiB;
constexpr size_t WS_INV = 593 * MiB;
constexpr size_t WS_IDX = 594 * MiB;
constexpr size_t WS_GATE = 594 * MiB + 256 * 1024;
constexpr size_t WS_END = 609 * MiB;
constexpr int KU = 1152, UVZ = 3 * FW + 64, KUVZ = 3 * FW;

constexpr int LDS_BYTES = 155648;
constexpr int MISC_OFF = LDS_BYTES - 256;
constexpr size_t CTL_ZERO_BYTES = 65536;

__device__ __forceinline__ unsigned f2bf(float f) { unsigned u = __builtin_bit_cast(unsigned, f); return (u + 0x7fffu + ((u >> 16) & 1u)) >> 16; }
__device__ __forceinline__ unsigned pk2(float lo, float hi) { return f2bf(lo) | (f2bf(hi) << 16); }
__device__ __forceinline__ unsigned cvt_pk_bf16(float lo, float hi) { unsigned r; asm volatile("v_cvt_pk_bf16_f32 %0, %1, %2" : "=v"(r) : "v"(lo), "v"(hi)); return r; }
__device__ __forceinline__ float bf_lo(unsigned w) { return __builtin_bit_cast(float, w << 16); }
__device__ __forceinline__ float bf_hi(unsigned w) { return __builtin_bit_cast(float, w & 0xffff0000u); }
template <int CTRL> __device__ __forceinline__ float dpp_mov(float v) { return __builtin_bit_cast(float, __builtin_amdgcn_update_dpp(0, __builtin_bit_cast(int, v), CTRL, 0xf, 0xf, false)); }
__device__ __forceinline__ float lane_val(float v, int l) { return __builtin_bit_cast(float, __builtin_amdgcn_readlane(__builtin_bit_cast(int, v), l)); }
__device__ __forceinline__ float wave_sum(float v) {
    v += dpp_mov<0xB1>(v); v += dpp_mov<0x4E>(v); v += dpp_mov<0x141>(v); v += dpp_mov<0x140>(v);
    return (lane_val(v, 0) + lane_val(v, 16)) + (lane_val(v, 32) + lane_val(v, 48));
}
__device__ __forceinline__ float sigmoidf_fast(float x) { return __builtin_amdgcn_rcpf(1.0f + __builtin_amdgcn_exp2f(-1.4426950408889634f * x)); }
#define LDS_WAIT() asm volatile("s_waitcnt lgkmcnt(0)" ::: "memory")
#define VM_WAIT() asm volatile("s_waitcnt vmcnt(0)" ::: "memory")

constexpr int BM = 256, BK = 64, HALF = 128, HTB = HALF * BK * 2, NXCD = 8, WGM = 8;
__device__ __forceinline__ int lds_byte(int r, int c) { const int st = (r >> 4) * 2 + (c >> 5), rr = r & 15, cc = c & 31, ob = rr * 64 + cc * 2; return st * 1024 + (ob ^ (((ob >> 9) & 1) << 5)); }
__device__ __forceinline__ void stage_rc(int b, int& R, int& C) { const int st = b / 1024, sb = b % 1024, swz = sb ^ (((sb >> 9) & 1) << 5); R = (st >> 1) * 16 + swz / 64; C = (st & 1) * 32 + (swz % 64) / 2; }
__device__ __forceinline__ int perm32(int rho) { const int n = rho >> 4, i = rho & 15; return 8 * (i >> 2) + 4 * n + (i & 3); }

enum EpiMode { EPI_STORE = 0, EPI_PG = 1, EPI_GATED = 2, EPI_MIRROR = 3, EPI_SWIGLU = 5, EPI_ROWSCALE = 6 };
struct GemmDesc {
    const char* A; const char* B;
    int lda, ldb, K;
    int nM, nN, nZ;
    long sAz, sAm, sBz, sBn;
    int rz, rm;
    int mode, perm;
    int coff;
    int hook_t;
    const void* gidx;
    void* O; int ldc; long oz;
    const void* P1; const void* P2;
};
struct Unit { unsigned A, B; int row0, col0, z; };

__device__ __forceinline__ bool unit_next(const GemmDesc& d, int i, int G, int c, Unit& u) {
    if (c < 0) return false;
    const int nwg = d.nM * d.nN; const long L = (long)i * G + c;
    if (L >= (long)nwg * d.nZ) return false;
    const int z = (int)(L / nwg); int wgid = (int)(L % nwg);
    { const int q = nwg / NXCD, r = nwg % NXCD, xcd = wgid % NXCD, off = wgid / NXCD; wgid = (xcd < r ? xcd * (q + 1) : r * (q + 1) + (xcd - r) * q) + off; }
    const int nig = WGM * d.nN, gid = wgid / nig, fm = gid * WGM, gsz = (d.nM - fm) < WGM ? (d.nM - fm) : WGM;
    const int pm = fm + ((wgid % nig) % gsz), pn = (wgid % nig) / gsz;
    u.A = (unsigned)((long)z * d.sAz + (long)pm * d.sAm); u.B = (unsigned)((long)z * d.sBz + (long)pn * d.sBn);
    u.row0 = z * d.rz + pm * d.rm; u.col0 = pn * BM; u.z = z; return true;
}

__device__ __forceinline__ void epilogue(const GemmDesc& d, const f32x4 (&acc)[2][2][4][2], const Unit& u, int wr, int wc, int fr, int fq) {
    const int rowb = u.row0 + wr * 64 + fr;
    if (d.mode == EPI_STORE) {
        bf16_t* O = (bf16_t*)d.O + (size_t)u.z * d.oz; const int col0 = u.col0 + wc * 32 + 8 * fq;
#pragma unroll
        for (int ai = 0; ai < 2; ++ai)
#pragma unroll
            for (int m = 0; m < 4; ++m) { bf16_t* rowp = O + (size_t)(rowb + ai * HALF + m * 16) * d.ldc + col0;
#pragma unroll
                for (int bj = 0; bj < 2; ++bj) { const f32x4 v0 = acc[ai][bj][m][0], v1 = acc[ai][bj][m][1];
                    u32x4 w; w.x = cvt_pk_bf16(v0[0], v0[1]); w.y = cvt_pk_bf16(v0[2], v0[3]); w.z = cvt_pk_bf16(v1[0], v1[1]); w.w = cvt_pk_bf16(v1[2], v1[3]);
                    *(u32x4*)(rowp + bj * HALF) = w; } }
    } else if (d.mode == EPI_MIRROR) {
        bf16_t* O = (bf16_t*)d.O; const int col0 = u.col0 + wc * 32 + 8 * fq; const float sgn = d.oz ? -1.0f : 1.0f;
        const int kb = (u.row0 & (SEQ - 1)) + wr * 64 + fr, zb = u.row0 & ~(SEQ - 1);
#pragma unroll
        for (int ai = 0; ai < 2; ++ai)
#pragma unroll
            for (int m = 0; m < 4; ++m) { const int k = kb + ai * HALF + m * 16; bf16_t* rowp = O + (size_t)(zb + k) * UVZ + col0; bf16_t* rowm = O + (size_t)(zb + SEQ - k) * UVZ + col0;
#pragma unroll
                for (int bj = 0; bj < 2; ++bj) { const f32x4 v0 = acc[ai][bj][m][0], v1 = acc[ai][bj][m][1];
                    u32x4 w; w.x = cvt_pk_bf16(v0[0], v0[1]); w.y = cvt_pk_bf16(v0[2], v0[3]); w.z = cvt_pk_bf16(v1[0], v1[1]); w.w = cvt_pk_bf16(v1[2], v1[3]);
                    *(u32x4*)(rowp + bj * HALF) = w;
                    if (k > 0) { u32x4 x; x.x = cvt_pk_bf16(sgn * v0[0], sgn * v0[1]); x.y = cvt_pk_bf16(sgn * v0[2], sgn * v0[3]); x.z = cvt_pk_bf16(sgn * v1[0], sgn * v1[1]); x.w = cvt_pk_bf16(sgn * v1[2], sgn * v1[3]);
                        *(u32x4*)(rowm + bj * HALF) = x; } } }
    } else if (d.mode == EPI_PG) {
        if (d.perm) {
            bf16_t* O = (bf16_t*)d.O; const int col0 = u.col0 + wc * 32 + 8 * fq;
#pragma unroll
            for (int ai = 0; ai < 2; ++ai)
#pragma unroll
                for (int m = 0; m < 4; ++m) { bf16_t* rowp = O + (size_t)(rowb + ai * HALF + m * 16) * FW + col0;
#pragma unroll
                    for (int bj = 0; bj < 2; ++bj) { const f32x4 v0 = acc[ai][bj][m][0], v1 = acc[ai][bj][m][1];
                        u32x4 w; w.x = cvt_pk_bf16(v0[0], v0[1]); w.y = cvt_pk_bf16(v0[2], v0[3]); w.z = cvt_pk_bf16(v1[0], v1[1]); w.w = cvt_pk_bf16(v1[2], v1[3]);
                        *(u32x4*)(rowp + bj * HALF) = w; } }
        } else {
            bf16_t* Rr = (bf16_t*)d.P1; bf16_t* Gp = Rr + (size_t)T * D; const float* bias = (const float*)d.P2;
            const int dc0 = (u.col0 >> 1) + wc * 32 + 8 * fq;
            f32x4 bf[2], bp[2];
#pragma unroll
            for (int bj = 0; bj < 2; ++bj) { bf[bj] = *(const f32x4*)(bias + dc0 + 4 * bj); bp[bj] = *(const f32x4*)(bias + D + dc0 + 4 * bj); }
#pragma unroll
            for (int ai = 0; ai < 2; ++ai)
#pragma unroll
                for (int m = 0; m < 4; ++m) { const size_t off = (size_t)(rowb + ai * HALF + m * 16) * D + dc0; float rr[8], gg[8];
#pragma unroll
                    for (int bj = 0; bj < 2; ++bj) { const f32x4 av = acc[ai][bj][m][0] + bf[bj], bv = acc[ai][bj][m][1] + bp[bj];
#pragma unroll
                        for (int j = 0; j < 4; ++j) { const float ea = __builtin_amdgcn_exp2f(-1.4426950408889634f * fmaxf(av[j], -30.f)), eb = __builtin_amdgcn_exp2f(-1.4426950408889634f * fmaxf(bv[j], -30.f));
                            gg[4 * bj + j] = __builtin_amdgcn_rcpf(1.0f + eb); rr[4 * bj + j] = (1.0f + eb) * __builtin_amdgcn_rcpf(1.0f + ea); } }
                    u32x4 w; w.x = cvt_pk_bf16(rr[0], rr[1]); w.y = cvt_pk_bf16(rr[2], rr[3]); w.z = cvt_pk_bf16(rr[4], rr[5]); w.w = cvt_pk_bf16(rr[6], rr[7]);
                    *(u32x4*)(Rr + off) = w;
                    u32x4 g; g.x = cvt_pk_bf16(gg[0], gg[1]); g.y = cvt_pk_bf16(gg[2], gg[3]); g.z = cvt_pk_bf16(gg[4], gg[5]); g.w = cvt_pk_bf16(gg[6], gg[7]);
                    *(u32x4*)(Gp + off) = g; }
        }
    } else if (d.mode == EPI_GATED) {
        bf16_t* O = (bf16_t*)d.O; const bf16_t* Gm = (const bf16_t*)d.P1; const int col0 = u.col0 + wc * 32 + 8 * fq;
#pragma unroll
        for (int ai = 0; ai < 2; ++ai) { u32x4 g[4][2];
#pragma unroll
            for (int m = 0; m < 4; ++m)
#pragma unroll
                for (int bj = 0; bj < 2; ++bj) g[m][bj] = *(const u32x4*)(Gm + (size_t)(rowb + ai * HALF + m * 16) * D + col0 + bj * HALF);
#pragma unroll
            for (int m = 0; m < 4; ++m) { const size_t r = (size_t)(rowb + ai * HALF + m * 16);
#pragma unroll
                for (int bj = 0; bj < 2; ++bj) { const f32x4 v0 = acc[ai][bj][m][0], v1 = acc[ai][bj][m][1]; const u32x4 q = g[m][bj];
                    u32x4 w; w.x = cvt_pk_bf16(v0[0] * bf_lo(q.x), v0[1] * bf_hi(q.x)); w.y = cvt_pk_bf16(v0[2] * bf_lo(q.y), v0[3] * bf_hi(q.y));
                    w.z = cvt_pk_bf16(v1[0] * bf_lo(q.z), v1[1] * bf_hi(q.z)); w.w = cvt_pk_bf16(v1[2] * bf_lo(q.w), v1[3] * bf_hi(q.w));
                    *(u32x4*)(O + r * D + col0 + bj * HALF) = w; } }
            asm volatile("" ::: "memory"); }
    } else if (d.mode == EPI_SWIGLU) {
        unsigned char* O = (unsigned char*)d.O; const int hc0 = (u.col0 >> 1) + wc * 16 + 4 * fq;
#pragma unroll
        for (int ai = 0; ai < 2; ++ai)
#pragma unroll
            for (int m = 0; m < 4; ++m) { unsigned char* rowp = O + (size_t)(rowb + ai * HALF + m * 16) * HP + hc0;
#pragma unroll
                for (int bj = 0; bj < 2; ++bj) { const f32x4 g = acc[ai][bj][m][0], up = acc[ai][bj][m][1]; float h[4];
#pragma unroll
                    for (int j = 0; j < 4; ++j) h[j] = g[j] * sigmoidf_fast(g[j]) * up[j];
                    int w = 0; w = __builtin_amdgcn_cvt_pk_fp8_f32(h[0], h[1], w, false); w = __builtin_amdgcn_cvt_pk_fp8_f32(h[2], h[3], w, true);
                    *(int*)(rowp + bj * 64) = w; } }
    } else {
        unsigned char* O = (unsigned char*)d.O; const float* gs = (const float*)d.P1; const int col0 = u.col0 + wc * 32 + 8 * fq;
        float scv[2][4];
#pragma unroll
        for (int ai = 0; ai < 2; ++ai)
#pragma unroll
            for (int m = 0; m < 4; ++m) scv[ai][m] = gs[(size_t)(rowb + ai * HALF + m * 16)];
#pragma unroll
        for (int ai = 0; ai < 2; ++ai)
#pragma unroll
            for (int m = 0; m < 4; ++m) { const size_t r = (size_t)(rowb + ai * HALF + m * 16); const float sc = scv[ai][m] * YSC; unsigned char* rowp = O + r * D + col0;
#pragma unroll
                for (int bj = 0; bj < 2; ++bj) { const f32x4 v0 = acc[ai][bj][m][0] * sc, v1 = acc[ai][bj][m][1] * sc; int w0 = 0, w1 = 0;
                    w0 = __builtin_amdgcn_cvt_pk_fp8_f32(v0[0], v0[1], w0, false); w0 = __builtin_amdgcn_cvt_pk_fp8_f32(v0[2], v0[3], w0, true);
                    w1 = __builtin_amdgcn_cvt_pk_fp8_f32(v1[0], v1[1], w1, false); w1 = __builtin_amdgcn_cvt_pk_fp8_f32(v1[2], v1[3], w1, true);
                    u32x2 w; w.x = (unsigned)w0; w.y = (unsigned)w1; *(u32x2*)(rowp + bj * HALF) = w; } }
    }
}

__device__ __forceinline__ void midk_scale(const GemmDesc& d, f32x4 (&acc)[2][2][4][2], const Unit& u, int wr, int wc, int fr, int fq) {
    typedef __attribute__((address_space(1))) const bf16_t* gptr;
    gptr p0 = (gptr)((const bf16_t*)d.P2 + (size_t)(u.row0 + wr * 64 + fr) * D + (u.col0 + wc * 32 + 8 * fq));
    asm volatile("" : "+v"(p0));
#pragma unroll
    for (int ai = 0; ai < 2; ++ai) { u32x4 g[4][2];
#pragma unroll
        for (int m = 0; m < 4; ++m)
#pragma unroll
            for (int bj = 0; bj < 2; ++bj) g[m][bj] = *(const __attribute__((address_space(1))) u32x4*)(p0 + (size_t)(ai * HALF + m * 16) * D + bj * HALF);
#pragma unroll
        for (int m = 0; m < 4; ++m)
#pragma unroll
            for (int bj = 0; bj < 2; ++bj) { const u32x4 q = g[m][bj]; f32x4& v0 = acc[ai][bj][m][0]; f32x4& v1 = acc[ai][bj][m][1];
                v0[0] *= bf_lo(q.x); v0[1] *= bf_hi(q.x); v0[2] *= bf_lo(q.y); v0[3] *= bf_hi(q.y); v1[0] *= bf_lo(q.z); v1[1] *= bf_hi(q.z); v1[2] *= bf_lo(q.w); v1[3] *= bf_hi(q.w); }
        asm volatile("" ::: "memory"); }
}

__device__ __forceinline__ void tile_prefetch(const void* base, int row0, int col0, LAS unsigned char* lds, int tid, int wid) {
    const char* p = (const char*)base + ((size_t)(row0 + (tid >> 1)) * D + col0) * 2 + (tid & 1) * 256;
    asm volatile("" : "+v"(p));
    LAS unsigned* dst = (LAS unsigned*)(lds + 131072 + wid * 512);
    __builtin_amdgcn_global_load_lds((const unsigned*)p, dst, 4, 0, 0);
    __builtin_amdgcn_global_load_lds((const unsigned*)(p + 128), dst + 64, 4, 0, 0);
}

template <bool GATHER, bool HOOK, bool FP8>
__device__ __forceinline__ void gemm_run(LAS unsigned char* lds, const GemmDesc& d, int G, int cblk, const int tid) {
    const int wid = __builtin_amdgcn_readfirstlane(tid >> 6), lane = tid & 63, wr = wid >> 2, wc = wid & 3, fr = lane & 15, fq = lane >> 4;
    const int nt = d.K / BK; const int c = cblk - d.coff;
    unsigned voffA[2], voffB[2];
#pragma unroll
    for (int i = 0; i < 2; ++i) { int R, C; stage_rc(tid * 16 + i * 8192, R, C); const int Rb = d.perm ? ((R & ~31) + perm32(R & 31)) : R;
        voffA[i] = (unsigned)(R * d.lda + C) * 2u; voffB[i] = (unsigned)(Rb * d.ldb + C) * 2u; }
    const unsigned kstep = BK * 2;
    const unsigned hstepA = (unsigned)HALF * d.lda * 2, hstepB = (unsigned)HALF * d.ldb * 2;
    const unsigned ldsw = (unsigned)wid * 1024u;
    const int aoff = lds_byte(wr * 64 + fr, fq * 8), boff = lds_byte(wc * 32 + fr, fq * 8);
#define PG8_SA(b, h) (((b) * 2 + (h)) * HTB)
#define PG8_SB(b, h) ((4 + (b) * 2 + (h)) * HTB)
#define PG8_LDA(dst, b, h) do { _Pragma("unroll") for (int m = 0; m < 4; ++m) _Pragma("unroll") for (int k = 0; k < 2; ++k) dst[m][k] = *(const LAS bf16x8*)(lds + PG8_SA(b, h) + aoff + m * 2048 + k * 1024); } while (0)
#define PG8_LDB(dst, b, h) do { _Pragma("unroll") for (int n = 0; n < 2; ++n) _Pragma("unroll") for (int k = 0; k < 2; ++k) dst[n][k] = *(const LAS bf16x8*)(lds + PG8_SB(b, h) + boff + n * 2048 + k * 1024); } while (0)
    int fscale = 124; asm volatile("" : "+v"(fscale));
#define PG8_MMA(ai, bj, At, Bt) do { __builtin_amdgcn_s_setprio(1); _Pragma("unroll") for (int m = 0; m < 4; ++m) _Pragma("unroll") for (int n = 0; n < 2; ++n) { \
        if constexpr (FP8) { const i32x8 b8_ = __builtin_shufflevector(__builtin_bit_cast(i32x4, Bt[n][0]), __builtin_bit_cast(i32x4, Bt[n][1]), 0, 1, 2, 3, 4, 5, 6, 7), \
                a8_ = __builtin_shufflevector(__builtin_bit_cast(i32x4, At[m][0]), __builtin_bit_cast(i32x4, At[m][1]), 0, 1, 2, 3, 4, 5, 6, 7); \
            asm volatile("v_mfma_scale_f32_16x16x128_f8f6f4 %0, %1, %2, %0, %3, %3 op_sel_hi:[0,0,0]" : "+v"(acc[ai][bj][m][n]) : "v"(b8_), "v"(a8_), "v"(fscale)); } \
        else { _Pragma("unroll") for (int k = 0; k < 2; ++k) acc[ai][bj][m][n] = __builtin_amdgcn_mfma_f32_16x16x32_bf16(Bt[n][k], At[m][k], acc[ai][bj][m][n], 0, 0, 0); } } \
        __builtin_amdgcn_s_setprio(0); } while (0)
#define PG8_WAIT_V(n) asm volatile("s_waitcnt vmcnt(" #n ")" ::: "memory")
#define PG8_WAIT_L(n) asm volatile("s_waitcnt lgkmcnt(" #n ")" ::: "memory")
#define PG8_BAR __builtin_amdgcn_s_barrier()
#define PG8_SCHED __builtin_amdgcn_sched_barrier(0)
    const unsigned stash = 131072u + (unsigned)tid * 32u; int cs = 0;
#define PG8_GATHER_OFFS(slot_, row0_) do { int gi_[2][2]; \
        _Pragma("unroll") for (int h_ = 0; h_ < 2; ++h_) _Pragma("unroll") for (int i_ = 0; i_ < 2; ++i_) { int R_, C_; stage_rc(tid * 16 + i_ * 8192, R_, C_); gi_[h_][i_] = ((const int*)d.gidx)[(row0_) + h_ * HALF + R_]; } \
        asm volatile("s_waitcnt vmcnt(0)" ::: "memory"); u32x4 o_; \
        { int R_, C_; stage_rc(tid * 16, R_, C_); o_.x = (unsigned)(gi_[0][0] * d.lda + C_) * 2u; o_.z = (unsigned)(gi_[1][0] * d.lda + C_) * 2u; } \
        { int R_, C_; stage_rc(tid * 16 + 8192, R_, C_); o_.y = (unsigned)(gi_[0][1] * d.lda + C_) * 2u; o_.w = (unsigned)(gi_[1][1] * d.lda + C_) * 2u; } \
        *(LAS u32x4*)(lds + stash + (slot_) * 16) = o_; } while (0)
#define PG8_STAGE(bufoff, rsrc, soff, voff) do { _Pragma("unroll") for (int _i = 0; _i < 2; ++_i) \
        __builtin_amdgcn_raw_ptr_buffer_load_lds(rsrc, (LAS unsigned*)(lds + (bufoff) + ldsw + _i * 8192), 16, (voff)[_i], (soff), 0, 0); } while (0)
#define PG8_STAGE_G(bufoff, soff, slot_, h_) do { const u32x2 o_ = *(const LAS u32x2*)(lds + stash + (slot_) * 16 + (h_) * 8); \
        __builtin_amdgcn_raw_ptr_buffer_load_lds(rsrcA, (LAS unsigned*)(lds + (bufoff) + ldsw), 16, o_.x, (soff), 0, 0); \
        __builtin_amdgcn_raw_ptr_buffer_load_lds(rsrcA, (LAS unsigned*)(lds + (bufoff) + ldsw + 8192), 16, o_.y, (soff), 0, 0); } while (0)
#define PG8_STAGE_A(bufoff, soff, slot_, h_) do { if constexpr (GATHER) PG8_STAGE_G(bufoff, soff, slot_, h_); else PG8_STAGE(bufoff, rsrcA, (soff) + (h_) * hstepA, voffA); } while (0)
#define PG8_STAGE_B(bufoff, soff) PG8_STAGE(bufoff, rsrcB, soff, voffB)
    const __amdgpu_buffer_rsrc_t rsrcA = __builtin_amdgcn_make_buffer_rsrc((void*)d.A, 0, 0x7fffffff, 0x00020000), rsrcB = __builtin_amdgcn_make_buffer_rsrc((void*)d.B, 0, 0x7fffffff, 0x00020000);
    Unit cur, nxt; int ui = 0;
    if (!unit_next(d, 0, G, c, cur)) return;
    f32x4 acc[2][2][4][2];
#pragma unroll
    for (int a = 0; a < 2; ++a)
#pragma unroll
        for (int b = 0; b < 2; ++b)
#pragma unroll
            for (int m = 0; m < 4; ++m)
#pragma unroll
                for (int n = 0; n < 2; ++n) acc[a][b][m][n] = (f32x4){0.f, 0.f, 0.f, 0.f};
    bf16x8 At[4][2], B0[2][2], B1[2][2];
    unsigned cA = cur.A, cB = cur.B;
    if constexpr (GATHER) PG8_GATHER_OFFS(cs, cur.row0);
    PG8_STAGE_B(PG8_SB(0, 0), cB); PG8_STAGE_B(PG8_SB(0, 1), cB + hstepB); PG8_STAGE_A(PG8_SA(0, 0), cA, cs, 0); PG8_STAGE_A(PG8_SA(0, 1), cA, cs, 1);
    if (wr == 1) PG8_BAR;
    PG8_WAIT_V(2); PG8_BAR;
    PG8_STAGE_B(PG8_SB(1, 0), cB + kstep); PG8_STAGE_A(PG8_SA(1, 0), cA + kstep, cs, 0); PG8_STAGE_B(PG8_SB(1, 1), cB + hstepB + kstep);
    PG8_WAIT_V(6); PG8_BAR;
    for (;;) {
        const bool has_next = unit_next(d, ui + 1, G, c, nxt);
        const unsigned nA = has_next ? nxt.A : cA, nB = has_next ? nxt.B : cB;
        if constexpr (GATHER) { if (has_next) PG8_GATHER_OFFS(cs ^ 1, nxt.row0); else { const u32x4 o_ = *(const LAS u32x4*)(lds + stash + cs * 16); *(LAS u32x4*)(lds + stash + (cs ^ 1) * 16) = o_; } }
        for (int t = 0; t < nt; t += 2) {
            const bool last = (t == nt - 2);
            const unsigned a1 = cA + (unsigned)(t + 1) * kstep;
            const unsigned a2 = last ? nA : cA + (unsigned)(t + 2) * kstep, b2 = last ? nB : cB + (unsigned)(t + 2) * kstep;
            const unsigned a3 = a2 + kstep, b3 = b2 + kstep;
            const int ns = last ? (cs ^ 1) : cs;
            if constexpr (HOOK) { if (d.hook_t == t) { midk_scale(d, acc, cur, wr, wc, fr, fq); } }
            PG8_LDB(B0, 0, 0); PG8_LDB(B1, 0, 1); PG8_SCHED; PG8_LDA(At, 0, 0); PG8_STAGE_A(PG8_SA(1, 1), a1, cs, 1);
            PG8_WAIT_V(8); PG8_WAIT_L(0); PG8_BAR; PG8_MMA(0, 0, At, B0); PG8_MMA(0, 1, At, B1); PG8_BAR; PG8_SCHED;
            PG8_LDA(At, 0, 1); PG8_STAGE_B(PG8_SB(0, 0), b2); PG8_STAGE_B(PG8_SB(0, 1), b2 + hstepB); PG8_STAGE_A(PG8_SA(0, 0), a2, ns, 0);
            PG8_WAIT_V(8); PG8_WAIT_L(0); PG8_BAR; PG8_MMA(1, 0, At, B0); PG8_MMA(1, 1, At, B1); PG8_BAR; PG8_SCHED;
            PG8_LDB(B0, 1, 0); PG8_LDB(B1, 1, 1); PG8_SCHED; PG8_LDA(At, 1, 0); PG8_STAGE_A(PG8_SA(0, 1), a2, ns, 1);
            PG8_WAIT_V(8); PG8_WAIT_L(0); PG8_BAR; PG8_MMA(0, 0, At, B0); PG8_MMA(0, 1, At, B1); PG8_BAR; PG8_SCHED;
            PG8_LDA(At, 1, 1); PG8_STAGE_B(PG8_SB(1, 0), b3); PG8_STAGE_B(PG8_SB(1, 1), b3 + hstepB); PG8_STAGE_A(PG8_SA(1, 0), a3, ns, 0);
            PG8_WAIT_V(8); PG8_WAIT_L(0); PG8_BAR; PG8_MMA(1, 0, At, B0); PG8_MMA(1, 1, At, B1); PG8_BAR; PG8_SCHED;
        }
        if (wr == 0) PG8_BAR;
        if constexpr (FP8) asm volatile("s_nop 15\n\ts_nop 15" ::: "memory");
        epilogue(d, acc, cur, wr, wc, fr, fq);
        if (!has_next) break;
#pragma unroll
        for (int a = 0; a < 2; ++a)
#pragma unroll
            for (int b = 0; b < 2; ++b)
#pragma unroll
                for (int m = 0; m < 4; ++m)
#pragma unroll
                    for (int n = 0; n < 2; ++n) acc[a][b][m][n] = (f32x4){0.f, 0.f, 0.f, 0.f};
        cur = nxt; cA = nA; cB = nB; ++ui;
        if constexpr (GATHER) cs ^= 1;
        if (wr == 1) PG8_BAR;
    }
    PG8_WAIT_V(0);
    PG8_BAR;
#undef PG8_SA
#undef PG8_SB
#undef PG8_STAGE
#undef PG8_LDA
#undef PG8_LDB
#undef PG8_MMA
#undef PG8_WAIT_V
#undef PG8_WAIT_L
#undef PG8_BAR
#undef PG8_SCHED
#undef PG8_GATHER_OFFS
#undef PG8_STAGE_G
#undef PG8_STAGE_A
#undef PG8_STAGE_B
}

struct Args { const float* in[17]; float* out; unsigned char* ws; int ph_lo, ph_hi; };
enum In { I_X = 0, I_NMIX, I_WIN, I_WFM, I_WPM, I_PSCALE, I_WBF, I_WBP, I_WGATE, I_BGATE, I_WOUT, I_NMOE, I_WROUTER, I_WEG, I_WEU, I_WED, I_NFINAL };

enum GemmId { G_MGU = 0, G_MGV, G_MGP, G_1A, G_1B, G_1C, G_DFTU, G_DFTV, G_4, G_OUT, G_GU, G_DOWN };
__device__ __forceinline__ void make_desc(int id, const Args& a, GemmDesc& d) {
    unsigned char* ws = a.ws;
    d.sAz = 0; d.sBz = 0; d.rz = 0; d.rm = BM; d.nZ = 1; d.coff = 0; d.oz = 0; d.P1 = nullptr; d.P2 = nullptr; d.perm = 1; d.mode = EPI_STORE; d.hook_t = -1; d.gidx = nullptr;
    switch (id) {
    case G_MGU:
    case G_MGV:
    case G_MGP:
        d.A = (const char*)(ws + (id == G_MGP ? WS_WBPT : WS_WBFT)); d.lda = FW; d.B = (const char*)(ws + (id == G_MGU ? WS_MIXC : id == G_MGV ? WS_MIXS : WS_MIXP)); d.ldb = 256; d.K = 256; d.nM = 8; d.nN = 1; d.nZ = 4;
        d.sAz = 256 * 2; d.sAm = (long)BM * FW * 2; d.sBz = 256 * 256 * 2; d.sBn = 0; d.O = ws + WS_WUVP + (size_t)(id - G_MGU) * FW * 2; d.ldc = UVZ; d.oz = 256; d.coff = 32 * (id - G_MGU); break;
    case G_1A:
        d.A = (const char*)(ws + WS_WTIN); d.lda = D; d.B = (const char*)(ws + WS_RA); d.ldb = D; d.K = D; d.nM = 4; d.nN = 8; d.nZ = 8;
        d.sAm = (long)BM * D * 2; d.sBz = (long)SEQ * D * 2; d.sBn = (long)BM * D * 2; d.O = ws + WS_RB; d.ldc = SEQ; d.oz = (long)FW * SEQ; break;
    case G_1B:
        d.A = (const char*)(ws + WS_RA); d.lda = D; d.B = (const char*)(ws + WS_WTIN + (size_t)FW * D * 2); d.ldb = D; d.K = D; d.nM = T / BM; d.nN = 4;
        d.sAm = (long)BM * D * 2; d.sBn = (long)BM * D * 2; d.mode = EPI_PG; d.perm = 1; d.O = ws + WS_RC; d.ldc = FW; d.P1 = ws + WS_RD; d.P2 = a.in[I_BGATE]; break;
    case G_1C:
        d.A = (const char*)(ws + WS_RE); d.lda = D / 2; d.B = (const char*)(ws + WS_WTG); d.ldb = D / 2; d.K = D / 2; d.nM = T / BM; d.nN = 16;
        d.sAm = (long)BM * D; d.sBn = (long)BM * D; d.mode = EPI_PG; d.perm = 0; d.O = ws + WS_RC; d.ldc = FW; d.P1 = ws + WS_RD; d.P2 = a.in[I_BGATE]; break;
    case G_DFTU:
    case G_DFTV:
        { const int ku = (id == G_DFTU ? KU : FW);
        d.A = (const char*)(ws + (id == G_DFTU ? WS_TC : WS_TS)); d.lda = ku; d.B = (const char*)(ws + (id == G_DFTU ? WS_PP : WS_PM)); d.ldb = ku; d.K = ku; d.nM = 4; d.nN = 4; d.nZ = 8;
        d.sAm = (long)BM * ku * 2; d.sBz = (long)FW * ku * 2; d.sBn = (long)BM * ku * 2; d.rz = SEQ; d.mode = EPI_MIRROR; d.O = ws + WS_RE + (id == G_DFTV ? FW * 2 : 0); d.ldc = UVZ; d.oz = (id == G_DFTV); d.coff = (id == G_DFTV ? 128 : 0); }
        break;
    case G_4:
        d.A = (const char*)(ws + WS_RE); d.lda = UVZ; d.B = (const char*)(ws + WS_WUVP); d.ldb = UVZ; d.K = KUVZ; d.nM = T / BM; d.nN = 8;
        d.sAm = (long)BM * UVZ * 2; d.sBn = (long)BM * UVZ * 2; d.mode = EPI_GATED; d.O = ws + WS_RA; d.ldc = D; d.hook_t = (2 * FW / BK);
        d.P1 = ws + WS_RD + (size_t)T * D * 2; d.P2 = ws + WS_RD; break;
    case G_OUT:
        d.A = (const char*)(ws + WS_RA); d.lda = D; d.B = (const char*)(ws + WS_WOUT); d.ldb = D; d.K = D; d.nM = T / BM; d.nN = 8;
        d.sAm = (long)BM * D * 2; d.sBn = (long)BM * D * 2; d.mode = EPI_STORE; d.O = a.out; d.ldc = 2 * D; break;
    case G_GU:
        d.A = (const char*)(ws + WS_RA); d.lda = D / 2; d.B = (const char*)(ws + WS_WGU); d.ldb = D / 2; d.K = D / 2; d.nM = BATCH; d.nN = 11; d.nZ = NE;
        d.sAz = 0; d.sAm = (long)SEQ * D; d.sBz = (long)2 * FF * D; d.sBn = (long)BM * D; d.rz = BM; d.rm = NE * BM;
        d.mode = EPI_SWIGLU; d.perm = 0; d.O = ws + WS_RB; d.ldc = FF; d.gidx = ws + WS_IDX; break;
    default:
        d.A = (const char*)(ws + WS_RB); d.lda = HP / 2; d.B = (const char*)(ws + WS_WD); d.ldb = HP / 2; d.K = HP / 2; d.nM = BATCH; d.nN = 8; d.nZ = NE;
        d.sAz = (long)BM * HP; d.sAm = (long)NE * BM * HP; d.sBz = (long)D * HP; d.sBn = (long)BM * HP; d.rz = BM; d.rm = NE * BM;
        d.mode = EPI_ROWSCALE; d.O = ws + WS_RD; d.ldc = D; d.P1 = ws + WS_GATE; break;
    }
}

__device__ __forceinline__ void transpose_tile(const float* src, int ldw, bf16_t* dbase, int ldt, int il, LAS float* scr, int lane) {
    (void)scr; (void)il;
    f32x4 v[16]; const int kb = lane >> 4, n4 = 4 * (lane & 15);
#pragma unroll
    for (int j = 0; j < 16; ++j) v[j] = *(const f32x4*)(src + (size_t)(16 * kb + j) * ldw + n4);
#pragma unroll
    for (int i = 0; i < 4; ++i) { u32x4 o0, o1;
        o0.x = cvt_pk_bf16(v[0][i], v[1][i]); o0.y = cvt_pk_bf16(v[2][i], v[3][i]); o0.z = cvt_pk_bf16(v[4][i], v[5][i]); o0.w = cvt_pk_bf16(v[6][i], v[7][i]);
        o1.x = cvt_pk_bf16(v[8][i], v[9][i]); o1.y = cvt_pk_bf16(v[10][i], v[11][i]); o1.z = cvt_pk_bf16(v[12][i], v[13][i]); o1.w = cvt_pk_bf16(v[14][i], v[15][i]);
        bf16_t* rp = dbase + (size_t)(n4 + i) * ldt + 16 * kb; *(u32x4*)rp = o0; *(u32x4*)(rp + 8) = o1; }
}

__device__ __forceinline__ void transpose_tile_f8(const float* src, int ldw, unsigned char* dmat, int ldt, int n0, int il, int up16, float scale, LAS float* scr, int lane) {
    (void)scr;
    f32x4 v[16]; const int kb = lane >> 3, n4 = 4 * (lane & 7);
#pragma unroll
    for (int j = 0; j < 16; ++j) v[j] = *(const f32x4*)(src + (size_t)(16 * kb + j) * ldw + n4);
#pragma unroll
    for (int i = 0; i < 4; ++i) { i32x4 o;
#pragma unroll
        for (int q = 0; q < 4; ++q) { int w = 0; w = __builtin_amdgcn_cvt_pk_fp8_f32(v[4 * q][i] * scale, v[4 * q + 1][i] * scale, w, false); w = __builtin_amdgcn_cvt_pk_fp8_f32(v[4 * q + 2][i] * scale, v[4 * q + 3][i] * scale, w, true); o[q] = w; }
        const int hn = n0 + n4 + i; const int dd_ = hn & 127;
        const int ro = il == 1 ? ((hn >> 7) * 256 + ((hn >> 6) & 1) * 128 + ((hn >> 4) & 3) * 32 + (hn & 15) + up16)
                     : il == 2 ? (((hn & 2047) >> 7) * 256 + 128 * ((dd_ >> 2) & 1) + 32 * (dd_ >> 5) + 16 * (hn >> 11) + 4 * ((dd_ >> 3) & 3) + (dd_ & 3)) : hn;
        __builtin_nontemporal_store(o, (i32x4*)(dmat + (size_t)ro * ldt + 16 * kb)); }
}

__device__ __forceinline__ void p0_items(const Args& a, LAS unsigned char* lds, int gw, int NGW, int wave, int lane, int it_lo, int it_hi) {
    unsigned char* ws = a.ws;
    LAS float* scr = (LAS float*)(lds + wave * (64 * 68 * 4));
    constexpr int I0 = 1024, I1 = 2048, I2 = 512, I3 = 512, I4 = 1024, IE = 16 * 704;
    constexpr int NITEMS = I0 + I1 + I2 + I3 + I4 + 3 * IE;
    (void)NITEMS;
    for (int it = it_lo + gw; it < it_hi; it += NGW) {
        int r = it; const float* src; int ldw, ldt, il = 0; bf16_t* db;
        if (r < I0) { const int kb = r / 32, nb = r % 32; src = a.in[I_WIN] + (size_t)(64 * kb) * D + 64 * nb; ldw = D; ldt = D; db = (bf16_t*)(ws + WS_WTIN) + (size_t)(64 * nb) * D + 64 * kb; }
        else if ((r -= I0) < I1) { const int kb = r / 128, nb = r % 128;
            transpose_tile_f8(a.in[I_WGATE] + (size_t)(128 * kb) * (2 * D) + 32 * nb, 2 * D, ws + WS_WTG + 128 * kb, D, 32 * nb, 2, 0, 64.0f, scr, lane); continue; }
        else if ((r -= I1) < I2) { const int kb = r / 32, nb = r % 32; src = a.in[I_WBF] + (size_t)(64 * kb) * D + 64 * nb; ldw = D; ldt = FW; db = (bf16_t*)(ws + WS_WBFT) + (size_t)(64 * nb) * FW + 64 * kb; }
        else if ((r -= I2) < I3) { const int kb = r / 32, nb = r % 32; src = a.in[I_WBP] + (size_t)(64 * kb) * D + 64 * nb; ldw = D; ldt = FW; db = (bf16_t*)(ws + WS_WBPT) + (size_t)(64 * nb) * FW + 64 * kb; }
        else if ((r -= I3) < I4) { const int kb = r / 32, nb = r % 32; src = a.in[I_WOUT] + (size_t)(64 * kb) * D + 64 * nb; ldw = D; ldt = D; db = (bf16_t*)(ws + WS_WOUT) + (size_t)(64 * nb) * D + 64 * kb; }
        else if ((r -= I4) < 2 * IE) { const int up = r >= IE; if (up) r -= IE; const int e = r / 704, q = r % 704, kb = q / 44, nb = q % 44;
            src = (up ? a.in[I_WEU] : a.in[I_WEG]) + (size_t)e * D * FF + (size_t)(128 * kb) * FF + 32 * nb;
            transpose_tile_f8(src, FF, ws + WS_WGU + (size_t)e * 2 * FF * D + 128 * kb, D, 32 * nb, 1, 16 * up, 64.0f, scr, lane); continue; }
        else { r -= 2 * IE; const int e = r / 704, q = r % 704, kb = q / 64, nb = q % 64;
            transpose_tile_f8(a.in[I_WED] + (size_t)e * FF * D + (size_t)(128 * kb) * D + 32 * nb, D, ws + WS_WD + (size_t)e * D * HP + 128 * kb, HP, 32 * nb, 0, 0, 64.0f, scr, lane); continue; }
        transpose_tile(src, ldw, db, ldt, il, scr, lane);
    }
}
constexpr int P0_NBASE = 1024 + 2048 + 512 + 512, P0_NITEMS = P0_NBASE + 1024 + 3 * 16 * 704;
__device__ __forceinline__ void p0_prologue(const Args& a, LAS unsigned char* lds, int gw, int NGW, int wave, int lane) {
    unsigned char* ws = a.ws;
    p0_items(a, lds, gw, NGW, wave, lane, 0, P0_NBASE);
    const int gt = gw * 64 + lane, NGT = NGW * 64;
    for (int i = gt; i < FW * 256 / 4; i += NGT) { const f32x4 v = *(const f32x4*)(a.in[I_WPM] + 4 * (size_t)i);
        const int g = i / (256 * 64), c2 = (i % 64) * 4; const f32x4 sc = *(const f32x4*)(a.in[I_PSCALE] + g * 256 + c2);
        u32x2 o; o.x = pk2(v[0] * sc[0], v[1] * sc[1]); o.y = pk2(v[2] * sc[2], v[3] * sc[3]); *(u32x2*)((bf16_t*)(ws + WS_MIXP) + 4 * (size_t)i) = o; }
    { LAS float* ct = (LAS float*)(lds + 147456);
        for (int i = lane + 64 * wave; i < 256; i += 64 * NWAVES) ct[i] = cospif((float)i * (1.0f / 128.0f));
        LDS_WAIT(); __syncthreads();
        for (int i = gt; i < 4 * 256 * 64; i += NGT) { const int c2 = (i & 63) * 4, cp = (i >> 6) & 255, g = i >> 14; const float* w = a.in[I_WFM] + (size_t)g * 65536 + c2;
            f32x4 sc_ = {0.f, 0.f, 0.f, 0.f}, ss_ = {0.f, 0.f, 0.f, 0.f};
#pragma unroll 8
            for (int c = 0; c < 256; ++c) { const f32x4 wv = *(const f32x4*)(w + (size_t)c * 256); const int ph = (c * cp) & 255; sc_ += wv * ct[ph]; ss_ += wv * ct[(ph - 64) & 255]; }
            const size_t o = (size_t)g * 65536 + (size_t)cp * 256 + c2;
            u32x2 oc; oc.x = pk2(sc_[0] * 0.0625f, sc_[1] * 0.0625f); oc.y = pk2(sc_[2] * 0.0625f, sc_[3] * 0.0625f); *(u32x2*)((bf16_t*)(ws + WS_MIXC) + o) = oc;
            u32x2 os; os.x = pk2(-ss_[0] * 0.0625f, -ss_[1] * 0.0625f); os.y = pk2(-ss_[2] * 0.0625f, -ss_[3] * 0.0625f); *(u32x2*)((bf16_t*)(ws + WS_MIXS) + o) = os; } }
    for (int i = gt; i < NE * D * 8; i += NGT) *(i32x4*)(ws + WS_WD + (size_t)(i >> 3) * HP + FF + 16 * (i & 7)) = (i32x4){0, 0, 0, 0};
    for (int i = gt; i < FW * KU / 2; i += NGT) { const int k = i / (KU / 2), n = (i % (KU / 2)) * 2; float o2[2];
#pragma unroll
        for (int q = 0; q < 2; ++q) { const int ph = (k * (n + q)) & (SEQ - 1); o2[q] = (n + q <= FW) ? cospif((float)ph * (1.0f / 1024.0f)) * 0.02209708691207961f : 0.f; }
        *(unsigned*)((bf16_t*)(ws + WS_TC) + (size_t)k * KU + n) = pk2(o2[0], o2[1]); }
    for (int i = gt; i < FW * FW / 2; i += NGT) { const int k = i / (FW / 2), n = (i % (FW / 2)) * 2; float o2[2];
#pragma unroll
        for (int q = 0; q < 2; ++q) { const int ph = (k * (n + q)) & (SEQ - 1); o2[q] = sinpif((float)ph * (1.0f / 1024.0f)) * 0.02209708691207961f; }
        *(unsigned*)((bf16_t*)(ws + WS_TS) + (size_t)k * FW + n) = pk2(o2[0], o2[1]); }
    const float* gm = a.in[I_NMIX];
    for (int m = gw; m < T; m += NGW) { const f32x4* xr = (const f32x4*)(a.in[I_X] + (size_t)m * D) + lane; f32x4 v[8]; float s = 0.f;
#pragma unroll
        for (int j = 0; j < 8; ++j) { v[j] = __builtin_nontemporal_load(xr + 64 * j); s += (v[j][0] * v[j][0] + v[j][1] * v[j][1]) + (v[j][2] * v[j][2] + v[j][3] * v[j][3]); }
        const float rstd = 1.0f / sqrtf(wave_sum(s) * (1.0f / D) + EPS);
        u32x2* o8 = (u32x2*)((bf16_t*)(ws + WS_RA) + (size_t)m * D) + lane; unsigned* o4 = (unsigned*)(ws + WS_RE + (size_t)m * D) + lane;
#pragma unroll
        for (int j = 0; j < 8; ++j) { const f32x4 g = ((const f32x4*)gm)[lane + 64 * j]; const f32x4 uv = v[j] * g * rstd; u32x2 o; o.x = pk2(uv[0], uv[1]); o.y = pk2(uv[2], uv[3]); o8[64 * j] = o;
            int w = 0; w = __builtin_amdgcn_cvt_pk_fp8_f32(uv[0], uv[1], w, false); w = __builtin_amdgcn_cvt_pk_fp8_f32(uv[2], uv[3], w, true); o4[64 * j] = (unsigned)w; } }
}

__device__ __forceinline__ void p3_fold(const Args& a, int gw, int NGW, int lane) {
    const bf16_t* PT = (const bf16_t*)(a.ws + WS_RB); bf16_t* PP = (bf16_t*)(a.ws + WS_PP); bf16_t* PM = (bf16_t*)(a.ws + WS_PM); bf16_t* Z = (bf16_t*)(a.ws + WS_RE);
    for (int row = gw; row < BATCH * FW; row += NGW) { const bf16_t* p = PT + (size_t)row * SEQ;
        u32x4 X[2], M[2]; unsigned E[2];
#pragma unroll
        for (int j = 0; j < 2; ++j) { const int n0 = 8 * lane + 512 * j; X[j] = *(const u32x4*)(p + n0); M[j] = *(const u32x4*)(p + 2040 - n0); E[j] = (n0 > 0) ? (unsigned)p[SEQ - n0] : 0u; }
        const float xm = bf_lo((unsigned)p[FW]); float alt = 0.f;
#pragma unroll
        for (int j = 0; j < 2; ++j) { const int n0 = 8 * lane + 512 * j;
            float x[8], m[8], y[8]; x[0] = bf_lo(X[j].x); x[1] = bf_hi(X[j].x); x[2] = bf_lo(X[j].y); x[3] = bf_hi(X[j].y); x[4] = bf_lo(X[j].z); x[5] = bf_hi(X[j].z); x[6] = bf_lo(X[j].w); x[7] = bf_hi(X[j].w);
            m[0] = bf_lo(M[j].x); m[1] = bf_hi(M[j].x); m[2] = bf_lo(M[j].y); m[3] = bf_hi(M[j].y); m[4] = bf_lo(M[j].z); m[5] = bf_hi(M[j].z); m[6] = bf_lo(M[j].w); m[7] = bf_hi(M[j].w);
            y[0] = bf_lo(E[j]);
#pragma unroll
            for (int i = 1; i < 8; ++i) y[i] = m[8 - i];
            float sp[8], sm[8];
#pragma unroll
            for (int i = 0; i < 8; ++i) { sp[i] = x[i] + y[i]; sm[i] = x[i] - y[i]; alt += (i & 1) ? -sp[i] : sp[i]; }
            if (n0 == 0) sm[0] = 0.f;
            u32x4 wp, wm; wp.x = pk2(sp[0], sp[1]); wp.y = pk2(sp[2], sp[3]); wp.z = pk2(sp[4], sp[5]); wp.w = pk2(sp[6], sp[7]); wm.x = pk2(sm[0], sm[1]); wm.y = pk2(sm[2], sm[3]); wm.z = pk2(sm[4], sm[5]); wm.w = pk2(sm[6], sm[7]);
            *(u32x4*)(PP + (size_t)row * KU + n0) = wp; *(u32x4*)(PM + (size_t)row * FW + n0) = wm; }
        if (lane < 16) { u32x4 t = {0u, 0u, 0u, 0u}; if (lane == 0) t.x = f2bf(xm); *(u32x4*)(PP + (size_t)row * KU + FW + 8 * lane) = t; }
        alt = wave_sum(alt) + xm;
        if (lane == 0) { const int b = row >> 10, c = row & (FW - 1); Z[(size_t)(b * SEQ + FW) * UVZ + c] = (bf16_t)f2bf(alt * 0.02209708691207961f); Z[(size_t)(b * SEQ + FW) * UVZ + FW + c] = 0; } }
}

__device__ __forceinline__ void ld8(const bf16_t* p, float (&f)[8]) { const u32x4 w = *(const u32x4*)p; f[0] = bf_lo(w.x); f[1] = bf_hi(w.x); f[2] = bf_lo(w.y); f[3] = bf_hi(w.y); f[4] = bf_lo(w.z); f[5] = bf_hi(w.z); f[6] = bf_lo(w.w); f[7] = bf_hi(w.w); }
__device__ __forceinline__ void p3_pool(const Args& a, int gtid, int NGT) {
    const bf16_t* P = (const bf16_t*)(a.ws + WS_RC); bf16_t* Z = (bf16_t*)(a.ws + WS_RE);
    for (int idx = gtid; idx < BATCH * 128 * 128; idx += NGT) {
        const int cb = idx & 127, chunk = (idx >> 7) & 127, b = idx >> 14, half = 1 << (cb >> 5), i0 = chunk * 16;
        const bf16_t* Pb = P + (size_t)b * SEQ * FW + cb * 8;
        float sum[8];
#pragma unroll
        for (int q = 0; q < 8; ++q) sum[q] = 0.f;
        { u32x4 w[16];
#pragma unroll
          for (int k = 0; k < 16; ++k) { int r = i0 - half + k; r = r < 0 ? 0 : (r > SEQ - 1 ? SEQ - 1 : r); w[k] = *(const u32x4*)(Pb + (size_t)r * FW); }
#pragma unroll
          for (int k = 0; k < 16; ++k) { const int r = i0 - half + k; const float mk = (k < 2 * half && r >= 0 && r < SEQ) ? 1.f : 0.f;
              sum[0] += mk * bf_lo(w[k].x); sum[1] += mk * bf_hi(w[k].x); sum[2] += mk * bf_lo(w[k].y); sum[3] += mk * bf_hi(w[k].y); sum[4] += mk * bf_lo(w[k].z); sum[5] += mk * bf_hi(w[k].z); sum[6] += mk * bf_lo(w[k].w); sum[7] += mk * bf_hi(w[k].w); } }
#pragma unroll 1
        for (int g4 = 0; g4 < 4; ++g4) { const int ib = i0 + 4 * g4; u32x4 ws_[4], wa[4], wb[4];
#pragma unroll
            for (int t = 0; t < 4; ++t) { const int i = ib + t; int ra = i + half; ra = ra > SEQ - 1 ? SEQ - 1 : ra; int rb = i - half; rb = rb < 0 ? 0 : rb;
                ws_[t] = *(const u32x4*)(Pb + (size_t)i * FW); wa[t] = *(const u32x4*)(Pb + (size_t)ra * FW); wb[t] = *(const u32x4*)(Pb + (size_t)rb * FW); }
#pragma unroll
            for (int t = 0; t < 4; ++t) { const int i = ib + t;
                int l2 = i - half; if (l2 < 0) l2 = 0; int h2 = i + half; if (h2 > SEQ) h2 = SEQ;
                const float inv = 1.0f / (float)(h2 - l2);
                const float f[8] = {bf_lo(ws_[t].x), bf_hi(ws_[t].x), bf_lo(ws_[t].y), bf_hi(ws_[t].y), bf_lo(ws_[t].z), bf_hi(ws_[t].z), bf_lo(ws_[t].w), bf_hi(ws_[t].w)}; float o[8];
#pragma unroll
                for (int q = 0; q < 8; ++q) o[q] = sum[q] * inv - f[q];
                u32x4 w; w.x = pk2(o[0], o[1]); w.y = pk2(o[2], o[3]); w.z = pk2(o[4], o[5]); w.w = pk2(o[6], o[7]);
                *(u32x4*)(Z + (size_t)(b * SEQ + i) * UVZ + 2 * FW + cb * 8) = w;
                const float ma = (i + half < SEQ) ? 1.f : 0.f, mb = (i - half >= 0) ? 1.f : 0.f;
                sum[0] += ma * bf_lo(wa[t].x) - mb * bf_lo(wb[t].x); sum[1] += ma * bf_hi(wa[t].x) - mb * bf_hi(wb[t].x); sum[2] += ma * bf_lo(wa[t].y) - mb * bf_lo(wb[t].y); sum[3] += ma * bf_hi(wa[t].y) - mb * bf_hi(wb[t].y);
                sum[4] += ma * bf_lo(wa[t].z) - mb * bf_lo(wb[t].z); sum[5] += ma * bf_hi(wa[t].z) - mb * bf_hi(wb[t].z); sum[6] += ma * bf_lo(wa[t].w) - mb * bf_lo(wb[t].w); sum[7] += ma * bf_hi(wa[t].w) - mb * bf_hi(wb[t].w); } }
    }
}

__device__ __forceinline__ float reduce16(const float (&a)[16], int lane) {
    float b8[8], b4[4], b2[2];
    { const bool hi = lane & 32;
#pragma unroll
      for (int i = 0; i < 8; ++i) { const float snd = hi ? a[i] : a[i + 8], kp = hi ? a[i + 8] : a[i]; b8[i] = kp + __shfl_xor(snd, 32); } }
    { const bool hi = lane & 16;
#pragma unroll
      for (int i = 0; i < 4; ++i) { const float snd = hi ? b8[i] : b8[i + 4], kp = hi ? b8[i + 4] : b8[i]; b4[i] = kp + __shfl_xor(snd, 16); } }
    { const bool hi = lane & 8;
#pragma unroll
      for (int i = 0; i < 2; ++i) { const float snd = hi ? b4[i] : b4[i + 2], kp = hi ? b4[i + 2] : b4[i]; b2[i] = kp + __shfl_xor(snd, 8); } }
    const bool hi = lane & 4; const float snd = hi ? b2[0] : b2[1], kp = hi ? b2[1] : b2[0]; float r = kp + __shfl_xor(snd, 4);
    r += __shfl_xor(r, 2); r += __shfl_xor(r, 1);
    return r;
}
__device__ __forceinline__ void p6_rows(const Args& a, LAS unsigned char* lds, int gw, int NGW, int lane, int tid) {
    LAS float* wt = (LAS float*)lds;
    for (int i = tid; i < D * NE / 4; i += NTHR) { const int dd = i & (D - 1), eq = i >> 11; const f32x4 v = *(const f32x4*)(a.in[I_WROUTER] + (size_t)dd * NE + 4 * eq);
#pragma unroll
        for (int q = 0; q < 4; ++q) wt[(4 * eq + q) * D + dd] = v[q]; }
    LDS_WAIT(); __syncthreads();
    const float* gm = a.in[I_NMOE]; unsigned char* V = (unsigned char*)(a.ws + WS_RA); float* AFF = (float*)(a.ws + WS_AFF);
    for (int i = gw * 64 + lane; i < NPAN * CAP * 8; i += NGW * 64) *(i32x4*)(a.ws + WS_RB + (size_t)(i >> 3) * HP + FF + 16 * (i & 7)) = (i32x4){0, 0, 0, 0};
    const int eL = ((lane >> 5) & 1) * 8 + ((lane >> 4) & 1) * 4 + ((lane >> 3) & 1) * 2 + ((lane >> 2) & 1);
#pragma unroll 1
    for (int m0 = gw; m0 < T; m0 += 2 * NGW) {
        f32x4 v[2][8]; u32x2 dl[2][8];
#pragma unroll
        for (int r = 0; r < 2; ++r) { const int m = min(m0 + r * NGW, T - 1); const f32x4* xr = (const f32x4*)(a.in[I_X] + (size_t)m * D) + lane; const u32x2* dr = (const u32x2*)(a.out + (size_t)m * D) + lane;
#pragma unroll
            for (int j = 0; j < 8; ++j) { v[r][j] = __builtin_nontemporal_load(xr + 64 * j); dl[r][j] = dr[64 * j]; } }
#pragma unroll
        for (int r = 0; r < 2; ++r) { float s = 0.f;
#pragma unroll
            for (int j = 0; j < 8; ++j) { const u32x2 w = dl[r][j]; v[r][j][0] += bf_lo(w.x); v[r][j][1] += bf_hi(w.x); v[r][j][2] += bf_lo(w.y); v[r][j][3] += bf_hi(w.y);
                s += (v[r][j][0] * v[r][j][0] + v[r][j][1] * v[r][j][1]) + (v[r][j][2] * v[r][j][2] + v[r][j][3] * v[r][j][3]); }
            { const int mh = m0 + r * NGW;
              if (mh < T) { u32x2* hr = (u32x2*)(a.out + (size_t)mh * D) + lane;
#pragma unroll
                  for (int j = 0; j < 8; ++j) { u32x2 o; o.x = pk2(v[r][j][0], v[r][j][1]); o.y = pk2(v[r][j][2], v[r][j][3]); hr[64 * j] = o; } } }
            const float rstd = 1.0f / sqrtf(wave_sum(s) * (1.0f / D) + EPS);
            const float* gmp = gm; asm volatile("" : "+s"(gmp));
#pragma unroll
            for (int j = 0; j < 8; ++j) { const f32x4 g = ((const f32x4*)gmp)[lane + 64 * j]; v[r][j] = v[r][j] * g * rstd; }
            const int m = m0 + r * NGW;
            if (m < T) { unsigned* o4 = (unsigned*)(V + (size_t)m * D) + lane;
#pragma unroll
                for (int j = 0; j < 8; ++j) { int w = 0; w = __builtin_amdgcn_cvt_pk_fp8_f32(v[r][j][0], v[r][j][1], w, false); w = __builtin_amdgcn_cvt_pk_fp8_f32(v[r][j][2], v[r][j][3], w, true); o4[64 * j] = (unsigned)w; } } }
        float lg0 = 0.f, lg1 = 0.f;
#pragma unroll 1
        for (int e = 0; e < NE; ++e) { float a0 = 0.f, a1 = 0.f; const LAS float* we = wt + e * D + 4 * lane;
#pragma unroll
            for (int j = 0; j < 8; ++j) { const f32x4 w = *(const LAS f32x4*)(we + 256 * j);
                a0 += (v[0][j][0] * w[0] + v[0][j][1] * w[1]) + (v[0][j][2] * w[2] + v[0][j][3] * w[3]); a1 += (v[1][j][0] * w[0] + v[1][j][1] * w[1]) + (v[1][j][2] * w[2] + v[1][j][3] * w[3]); }
            a0 = wave_sum(a0); a1 = wave_sum(a1); if (eL == e) { lg0 = a0; lg1 = a1; } }
#pragma unroll
        for (int r = 0; r < 2; ++r) { const float lg = r ? lg1 : lg0; float mx = lg;
            mx = fmaxf(mx, dpp_mov<0x141>(mx)); mx = fmaxf(mx, dpp_mov<0x140>(mx));
            mx = fmaxf(fmaxf(lane_val(mx, 0), lane_val(mx, 16)), fmaxf(lane_val(mx, 32), lane_val(mx, 48)));
            const float ex = expf(lg - mx); float den = ex;
            den += dpp_mov<0x141>(den); den += dpp_mov<0x140>(den);
            den = (lane_val(den, 0) + lane_val(den, 16)) + (lane_val(den, 32) + lane_val(den, 48));
            const int m = m0 + r * NGW;
            if (m < T && (lane & 3) == 0) AFF[((size_t)(m >> 11) * NE + eL) * SEQ + (m & (SEQ - 1))] = ex / den; }
    }
    __syncthreads();
}

__device__ __forceinline__ void p7_topk(const Args& a, LAS unsigned char* lds, int G, const int tid) {
    LAS unsigned* red = (LAS unsigned*)lds;
    const int lane = tid & 63, wave = tid >> 6;
    const float* AFF = (const float*)(a.ws + WS_AFF); int* IDX = (int*)(a.ws + WS_IDX); float* GATE = (float*)(a.ws + WS_GATE); int* INV = (int*)(a.ws + WS_INV);
    for (int p = blockIdx.x; p < NPAN; p += G) {
        const int b = p >> 4, e = p & 15;
        unsigned v[4];
#pragma unroll
        for (int k = 0; k < 4; ++k) v[k] = __builtin_bit_cast(unsigned, AFF[((size_t)b * NE + e) * SEQ + 4 * tid + k]);
        unsigned prefix = 0u;
        for (int bit = 30; bit >= 0; --bit) {
            const unsigned Tt = prefix | (1u << bit); unsigned c = 0;
#pragma unroll
            for (int k = 0; k < 4; ++k) c += (unsigned)__popcll(__ballot(v[k] >= Tt));
            LAS unsigned* rb = red + (bit & 1) * 8;
            if (lane == 0) rb[wave] = c;
            LDS_WAIT(); __syncthreads();
            unsigned tot = 0;
#pragma unroll
            for (int w = 0; w < 8; ++w) tot += rb[w];
            if (tot >= (unsigned)CAP) prefix = Tt;
        }
        unsigned cg_ = 0, ce_ = 0;
#pragma unroll
        for (int k = 0; k < 4; ++k) { cg_ += v[k] > prefix; ce_ += v[k] == prefix; }
        unsigned sg = cg_, se = ce_;
#pragma unroll
        for (int o = 1; o < 64; o <<= 1) { const unsigned tg = __shfl_up(sg, o), te = __shfl_up(se, o); if (lane >= o) { sg += tg; se += te; } }
        LAS unsigned* sc = red + 64;
        __syncthreads();
        if (lane == 63) { sc[wave] = sg; sc[8 + wave] = se; }
        LDS_WAIT(); __syncthreads();
        unsigned bg = 0, be = 0, totg = 0;
#pragma unroll
        for (int w = 0; w < 8; ++w) { const unsigned xg = sc[w], xe = sc[8 + w]; if (w < wave) { bg += xg; be += xe; } totg += xg; }
        unsigned eg = bg + sg - cg_, ee = be + se - ce_;
        const unsigned need = (unsigned)CAP - totg;
#pragma unroll
        for (int k = 0; k < 4; ++k) { const int n = 4 * tid + k; int slot = -1;
            if (v[k] > prefix) { slot = (int)eg; ++eg; }
            else if (v[k] == prefix) { if (ee < need) slot = (int)(totg + ee); ++ee; }
            if (slot >= 0) { IDX[p * CAP + slot] = n; GATE[p * CAP + slot] = __builtin_bit_cast(float, v[k]); }
            INV[(size_t)(b * SEQ + n) * NE + e] = slot; }
        __syncthreads();
    }
}

__device__ __forceinline__ void p8_gather(const Args& a, int gw, int NGW, int lane) {
    const bf16_t* V = (const bf16_t*)(a.ws + WS_RA); bf16_t* Xs = (bf16_t*)(a.ws + WS_RD); const int* IDX = (const int*)(a.ws + WS_IDX);
    for (int r = gw; r < NPAN * CAP; r += NGW) { const int p = r >> 8, b = p >> 4; const int n = IDX[r];
        const u32x4* src = (const u32x4*)(V + (size_t)(b * SEQ + n) * D) + lane; u32x4* dst = (u32x4*)(Xs + (size_t)r * D) + lane;
        u32x4 t[4];
#pragma unroll
        for (int j = 0; j < 4; ++j) t[j] = src[64 * j];
#pragma unroll
        for (int j = 0; j < 4; ++j) dst[64 * j] = t[j]; }
}

__device__ __forceinline__ void p11_final(const Args& a, int gw, int NGW, int lane, float* dst) {
    float* out = a.out; const unsigned char* Y = (const unsigned char*)(a.ws + WS_RD); const int* INV = (const int*)(a.ws + WS_INV); const float* gf = a.in[I_NFINAL];
    for (int m = gw; m < T; m += NGW) { f32x4* xr = (f32x4*)(dst + (size_t)m * D) + lane; const u32x2* dr = (const u32x2*)(out + (size_t)m * D) + lane; f32x4 v[8];
#pragma unroll
        for (int j = 0; j < 8; ++j) { const u32x2 w = dr[64 * j]; v[j][0] = bf_lo(w.x); v[j][1] = bf_hi(w.x); v[j][2] = bf_lo(w.y); v[j][3] = bf_hi(w.y); }
        const int b = m >> 11;
        i32x4 iv[4];
#pragma unroll
        for (int q = 0; q < 4; ++q) iv[q] = *(const i32x4*)(INV + (size_t)m * NE + 4 * q);
#pragma unroll
        for (int e = 0; e < NE; ++e) { const int slot = __builtin_amdgcn_readfirstlane(iv[e >> 2][e & 3]);
            if (slot >= 0) { const unsigned* yr = (const unsigned*)(Y + ((size_t)(b * NE + e) * CAP + slot) * D) + lane;
#pragma unroll
                for (int j = 0; j < 8; ++j) { const unsigned w = yr[64 * j]; const f32x2 lo = __builtin_amdgcn_cvt_pk_f32_fp8((int)w, false), hi = __builtin_amdgcn_cvt_pk_f32_fp8((int)w, true);
                    v[j][0] += lo[0] * (1.0f / YSC); v[j][1] += lo[1] * (1.0f / YSC); v[j][2] += hi[0] * (1.0f / YSC); v[j][3] += hi[1] * (1.0f / YSC); } } }
        float s = 0.f;
#pragma unroll
        for (int j = 0; j < 8; ++j) s += (v[j][0] * v[j][0] + v[j][1] * v[j][1]) + (v[j][2] * v[j][2] + v[j][3] * v[j][3]);
        const float rstd = 1.0f / sqrtf(wave_sum(s) * (1.0f / D) + EPS);
#pragma unroll
        for (int j = 0; j < 8; ++j) { const f32x4 g = ((const f32x4*)gf)[lane + 64 * j]; __builtin_nontemporal_store(v[j] * g * rstd, xr + 64 * j); } }
}

#define XB_TMO      128
#define XB_XCNT(j)  (256  + 64 * (j))
#define XB_XSUB(j)  (1280 + 64 * (j))
#define XB_XGEN(j)  (2304 + 64 * (j))
#define XB_TOP      3328
#define XB_TOPGEN   3392
#define XCD_BAR_WORDS 3456
#define XB_SPIN_CAP (1u << 22)
__device__ __forceinline__ unsigned xb_ld(unsigned* p)              { return __hip_atomic_load(p, __ATOMIC_RELAXED, __HIP_MEMORY_SCOPE_AGENT); }
__device__ __forceinline__ unsigned xb_add(unsigned* p, unsigned v) { return __hip_atomic_fetch_add(p, v, __ATOMIC_RELAXED, __HIP_MEMORY_SCOPE_AGENT); }
__device__ __forceinline__ unsigned xb_xcc_id() { return (unsigned)__builtin_amdgcn_s_getreg((3 << 11) | 20) & 0xFu; }
#define XB_SPIN(cond, bar) do { unsigned _sp = 0; while (cond) { __builtin_amdgcn_s_sleep(1); \
    if ((++_sp & 255u) == 0u) { if (xb_ld(&(bar)[XB_TMO])) break; if (_sp > XB_SPIN_CAP) { atomicAdd(&(bar)[XB_TMO], 1u); break; } } } } while (0)
struct XcdBarrier { unsigned* bar; unsigned x; volatile LAS unsigned* st; };
__device__ __forceinline__ XcdBarrier xcd_barrier_post(unsigned* bar, volatile LAS unsigned* st) {
    XcdBarrier b; b.bar = bar; b.x = xb_xcc_id(); b.st = st;
    if (threadIdx.x == 0) (void)xb_add(&bar[XB_XCNT(b.x)], 1u);
    return b;
}
__device__ __forceinline__ void xcd_barrier_complete(unsigned* bar, unsigned x, unsigned& nloc, unsigned& nx) {
    const unsigned G = gridDim.x * gridDim.y * gridDim.z;
    unsigned sum, cnt, mine, sp = 0u;
    for (;;) {
        sum = 0u; cnt = 0u; mine = 0u;
#pragma unroll
        for (unsigned j = 0; j < 16; ++j) { const unsigned c = xb_ld(&bar[XB_XCNT(j)]); sum += c; cnt += (c > 0u) ? 1u : 0u; mine = (j == x) ? c : mine; }
        if (sum == G) break;
        __builtin_amdgcn_s_sleep(1);
        if ((++sp & 255u) == 0u) { if (xb_ld(&bar[XB_TMO])) break; if (sp > XB_SPIN_CAP) { atomicAdd(&bar[XB_TMO], 1u); break; } }
    }
    nloc = mine > 0u ? mine : 1u; nx = cnt > 0u ? cnt : 1u;
}
__device__ __forceinline__ void xcd_barrier(const XcdBarrier& b) {
    asm volatile("s_waitcnt vmcnt(0)" ::: "memory");
    __syncthreads();
    if (threadIdx.x == 0) {
        unsigned* bar = b.bar;
        __builtin_amdgcn_s_waitcnt(0);
        unsigned nloc = b.st[0], nx = b.st[1];
        if (nloc == 0u) { xcd_barrier_complete(bar, b.x, nloc, nx); b.st[0] = nloc; b.st[1] = nx; }
        const unsigned old = xb_add(&bar[XB_XSUB(b.x)], 1u);
        const unsigned gen = old / nloc;
        if (old + 1u == (gen + 1u) * nloc) {
            __builtin_amdgcn_fence(__ATOMIC_RELEASE, "agent");
            asm volatile("s_waitcnt vmcnt(0)" ::: "memory");
            const unsigned og = xb_add(&bar[XB_TOP], 1u);
            const unsigned tg = og / nx;
            if (og + 1u == (tg + 1u) * nx) xb_add(&bar[XB_TOPGEN], 1u);
            else XB_SPIN(xb_ld(&bar[XB_TOPGEN]) == tg, bar);
            __builtin_amdgcn_fence(__ATOMIC_ACQUIRE, "agent");
            xb_add(&bar[XB_XGEN(b.x)], 1u);
            asm volatile("s_waitcnt vmcnt(0)" ::: "memory");
        } else {
            XB_SPIN(xb_ld(&bar[XB_XGEN(b.x)]) == gen, bar);
            __builtin_amdgcn_fence(__ATOMIC_ACQUIRE, "agent");
            asm volatile("s_waitcnt vmcnt(0)" ::: "memory");
        }
    }
    __syncthreads();
}

__global__ void __launch_bounds__(NTHR, 2) fwd_kernel(Args args) {
    extern __shared__ __attribute__((aligned(16))) unsigned char lds_raw[];
    LAS unsigned char* lds = (LAS unsigned char*)lds_raw;
    volatile LAS unsigned* misc = (volatile LAS unsigned*)(lds + MISC_OFF);
    if (threadIdx.x < 64) misc[threadIdx.x] = 0u;
    __syncthreads();
    XcdBarrier xbar = xcd_barrier_post((unsigned*)args.ws, misc);
    const int G = gridDim.x, bx = blockIdx.x;
    const int vcu = (G % 8 == 0) ? (bx % 8) * (G / 8) + bx / 8 : bx;
    constexpr unsigned SEAMS = (1u << 0) | (1u << 7) | (1u << 8) | (1u << 10) | (1u << 11) | (1u << 12) | (1u << 13) | (1u << 14) | (1u << 15) | (1u << 16);
    const int slot = (bx % 8) >> 1;
    if (PROBE_SEL >= 0 && bx == 0 && threadIdx.x == 0) misc[7] = (unsigned)__builtin_amdgcn_s_memrealtime();
    for (int pos = args.ph_lo, rep = 0; pos < args.ph_hi; ) {
        int tid = threadIdx.x; asm volatile("" : "+v"(tid));
        int Gs = G; asm volatile("" : "+s"(Gs));
        const int lane = tid & 63, wave = __builtin_amdgcn_readfirstlane(tid >> 6);
        const int gw = vcu * NWAVES + wave, NGW = Gs * NWAVES;
        int step = pos;
        if (pos >= 4 && pos <= 7) { const int q = pos - 4; step = (q == slot) ? 100 : 4 + (q < slot ? q : q - 1); } else if (pos > 7) step = pos - 1;
        int gid = -1;
        switch (step) {
        case 0: p0_prologue(args, lds, gw, NGW, wave, lane); break;
        case 100: p0_items(args, lds, gw, NGW, wave, lane, P0_NBASE, P0_NITEMS); LDS_WAIT(); __syncthreads(); break;
        case 1: gid = G_MGU; break; case 2: gid = G_MGV; break; case 3: gid = G_MGP; break;
        case 4: gid = G_1A; break; case 5: gid = G_1B; break; case 6: gid = G_1C; break;
        case 7: p3_fold(args, gw, NGW, lane); p3_pool(args, gw * 64 + lane, NGW * 64); break;
        case 8: gid = G_DFTU; break; case 9: gid = G_DFTV; break;
        case 10: gid = G_4; break;
        case 11: gid = G_OUT; break;
        case 12: p6_rows(args, lds, gw, NGW, lane, tid); break;
        case 13: p7_topk(args, lds, Gs, tid); break;
        case 14: gid = G_GU; break;
        case 15: gid = G_DOWN; break;
        default: p11_final(args, gw, NGW, lane, args.out); break;
        }
        if (gid >= 0) { GemmDesc d_; make_desc(gid, args, d_); if (gid == G_GU) gemm_run<true, false, true>(lds, d_, Gs, bx, tid); else if (gid == G_DOWN || gid == G_1C) gemm_run<false, false, true>(lds, d_, Gs, bx, tid); else gemm_run<false, true, false>(lds, d_, Gs, bx, tid); }
        if (((PROBE_MASK >> pos) & 1u) && rep == 0) { rep = 1; xcd_barrier(xbar); continue; }
        rep = 0;
        if (((SEAMS >> pos) & 1u) && pos + 1 < args.ph_hi) xcd_barrier(xbar);
        ++pos;
        if (PROBE_SEL >= 0 && bx == 0 && tid == 0) misc[8 + pos] = (unsigned)__builtin_amdgcn_s_memrealtime();
    }
    if (PROBE_SEL >= 0 && bx == 0) { __syncthreads(); if (threadIdx.x == 0) { const unsigned t0 = (PROBE_SEL == 0) ? misc[7] : misc[8 + PROBE_SEL], t1 = misc[8 + PROBE_SEL_END];
        asm volatile("s_waitcnt vmcnt(0)" ::: "memory"); args.out[0] += (float)(t1 - t0) * 0.001f; } }
}

extern "C" void kernel_launch(void* const* d_in, const int* in_sizes, int n_in, void* d_out, int out_size, void* d_ws, size_t ws_size, hipStream_t stream) {
    static int grid = 0;
    if (grid == 0) {
        if (n_in != 17 || in_sizes[0] != T * D || out_size != T * D || ws_size < WS_END) { fprintf(stderr, "kernel_launch: unexpected shapes (n_in %d, in0 %d, out %d, ws %zu < %zu); nothing launched\n", n_in, n_in > 0 ? in_sizes[0] : -1, out_size, ws_size, (size_t)WS_END); grid = -1; return; }
        int dev = 0, cus = 0, per_cu = 0;
        if (hipGetDevice(&dev) != hipSuccess || hipDeviceGetAttribute(&cus, hipDeviceAttributeMultiprocessorCount, dev) != hipSuccess) { grid = -1; return; }
        if (hipFuncSetAttribute((const void*)fwd_kernel, hipFuncAttributeMaxDynamicSharedMemorySize, LDS_BYTES) != hipSuccess) { fprintf(stderr, "kernel_launch: hipFuncSetAttribute failed\n"); grid = -1; return; }
        if (hipOccupancyMaxActiveBlocksPerMultiprocessor(&per_cu, (const void*)fwd_kernel, NTHR, LDS_BYTES) != hipSuccess || per_cu < 1) { fprintf(stderr, "kernel_launch: occupancy query failed (%d)\n", per_cu); (void)hipGetLastError(); grid = -1; return; }
        grid = cus * per_cu;
        fprintf(stderr, "kernel_launch: %d CUs x %d per CU = grid %d\n", cus, per_cu, grid);
    }
    if (grid < 0) return;
    if (hipMemsetAsync(d_ws, 0, CTL_ZERO_BYTES, stream) != hipSuccess) { fprintf(stderr, "kernel_launch: hipMemsetAsync failed\n"); return; }
    Args a; memset(&a, 0, sizeof(a));
    for (int i = 0; i < 17; ++i) a.in[i] = (const float*)d_in[i];
    a.out = (float*)d_out; a.ws = (unsigned char*)d_ws;
    if (MK_N_LAUNCHES == 1) {
        a.ph_lo = 0; a.ph_hi = N_STEPS; void* kargs[] = {&a};
        hipError_t e = hipLaunchCooperativeKernel((const void*)fwd_kernel, dim3(grid), dim3(NTHR), kargs, LDS_BYTES, stream);
        if (e != hipSuccess) fprintf(stderr, "kernel_launch: cooperative launch failed: %s (grid %d)\n", hipGetErrorString(e), grid);
    } else {
        static const int cuts[12] = {0, 1, 8, 9, 11, 12, 13, 14, 15, 16, 17, 18};
        for (int p = 0; p < 11; ++p) { a.ph_lo = cuts[p]; a.ph_hi = cuts[p + 1]; void* kargs[] = {&a};
            hipError_t e = hipLaunchCooperativeKernel((const void*)fwd_kernel, dim3(grid), dim3(NTHR), kargs, LDS_BYTES, stream);
            if (e != hipSuccess) { fprintf(stderr, "kernel_launch: launch %d failed: %s (grid %d)\n", p, hipGetErrorString(e), grid); break; } }
    }
}
```

```cpp
#include <hip/hip_runtime.h>
#include <hip/hip_cooperative_groups.h>
#include <cstdio>
#include <cstdint>
#include <cstring>
namespace cg = cooperative_groups;

#define PROBE_MASK 0u
#define PROBE_SEL (-1)
#define PROBE_SEL_END (PROBE_SEL + 1)
#ifndef MK_N_LAUNCHES
#define MK_N_LAUNCHES 1
#endif

#define LAS __attribute__((address_space(3)))
typedef unsigned short bf16_t;
typedef short bf16x8 __attribute__((ext_vector_type(8)));
typedef float f32x4 __attribute__((ext_vector_type(4)));
typedef float f32x2 __attribute__((ext_vector_type(2)));
typedef unsigned u32x4 __attribute__((ext_vector_type(4)));
typedef unsigned u32x2 __attribute__((ext_vector_type(2)));
typedef int i32x4 __attribute__((ext_vector_type(4)));
typedef int i32x8 __attribute__((ext_vector_type(8)));

constexpr int BATCH = 8, SEQ = 2048, D = 2048, T = BATCH * SEQ;
constexpr int NE = 16, FF = 1408, CAP = 256, NPAN = BATCH * NE;
constexpr int FW = 1024;
constexpr int HP = 1536;
constexpr float EPS = 1e-6f;
constexpr float YSC = 16.0f;
constexpr int NWAVES = 8, NTHR = 512;
constexpr int N_STEPS = 18;

constexpr size_t MiB = 1u << 20;
constexpr size_t WS_WTIN = 2 * MiB;
constexpr size_t WS_WTG = 10 * MiB;
constexpr size_t WS_WBFT = 26 * MiB;
constexpr size_t WS_WBPT = 30 * MiB;
constexpr size_t WS_WUVP = 596 * MiB;
constexpr size_t WS_WOUT = 46 * MiB;
constexpr size_t WS_MIXC = 54 * MiB;
constexpr size_t WS_MIXS = 54 * MiB + 512 * 1024;
constexpr size_t WS_MIXP = 55 * MiB;
constexpr size_t WS_TC = 56 * MiB;
constexpr size_t WS_TS = 59 * MiB;
constexpr size_t WS_WGU = 64 * MiB;
constexpr size_t WS_WD = 152 * MiB;
constexpr size_t WS_RA = 200 * MiB;
constexpr size_t WS_RB = 264 * MiB;
constexpr size_t WS_RC = 296 * MiB;
constexpr size_t WS_PP = 328 * MiB;
constexpr size_t WS_PM = 346 * MiB;
constexpr size_t WS_RD = 364 * MiB;
constexpr size_t WS_RE = 492 * MiB;
constexpr size_t WS_AFF = 592 * MiB;
constexpr size_t WS_INV = 593 * MiB;
constexpr size_t WS_IDX = 594 * MiB;
constexpr size_t WS_GATE = 594 * MiB + 256 * 1024;
constexpr size_t WS_END = 609 * MiB;
constexpr int KU = 1152, UVZ = 3 * FW + 64, KUVZ = 3 * FW;

constexpr int LDS_BYTES = 155648;
constexpr int MISC_OFF = LDS_BYTES - 256;
constexpr size_t CTL_ZERO_BYTES = 65536;

__device__ __forceinline__ unsigned f2bf(float f) { unsigned u = __builtin_bit_cast(unsigned, f); return (u + 0x7fffu + ((u >> 16) & 1u)) >> 16; }
__device__ __forceinline__ unsigned pk2(float lo, float hi) { return f2bf(lo) | (f2bf(hi) << 16); }
__device__ __forceinline__ unsigned cvt_pk_bf16(float lo, float hi) { unsigned r; asm volatile("v_cvt_pk_bf16_f32 %0, %1, %2" : "=v"(r) : "v"(lo), "v"(hi)); return r; }
__device__ __forceinline__ float bf_lo(unsigned w) { return __builtin_bit_cast(float, w << 16); }
__device__ __forceinline__ float bf_hi(unsigned w) { return __builtin_bit_cast(float, w & 0xffff0000u); }
template <int CTRL> __device__ __forceinline__ float dpp_mov(float v) { return __builtin_bit_cast(float, __builtin_amdgcn_update_dpp(0, __builtin_bit_cast(int, v), CTRL, 0xf, 0xf, false)); }
__device__ __forceinline__ float lane_val(float v, int l) { return __builtin_bit_cast(float, __builtin_amdgcn_readlane(__builtin_bit_cast(int, v), l)); }
__device__ __forceinline__ float wave_sum(float v) {
    v += dpp_mov<0xB1>(v); v += dpp_mov<0x4E>(v); v += dpp_mov<0x141>(v); v += dpp_mov<0x140>(v);
    return (lane_val(v, 0) + lane_val(v, 16)) + (lane_val(v, 32) + lane_val(v, 48));
}
__device__ __forceinline__ float sigmoidf_fast(float x) { return __builtin_amdgcn_rcpf(1.0f + __builtin_amdgcn_exp2f(-1.4426950408889634f * x)); }
#define LDS_WAIT() asm volatile("s_waitcnt lgkmcnt(0)" ::: "memory")
#define VM_WAIT() asm volatile("s_waitcnt vmcnt(0)" ::: "memory")

constexpr int BM = 256, BK = 64, HALF = 128, HTB = HALF * BK * 2, NXCD = 8, WGM = 8;
__device__ __forceinline__ int lds_byte(int r, int c) { const int st = (r >> 4) * 2 + (c >> 5), rr = r & 15, cc = c & 31, ob = rr * 64 + cc * 2; return st * 1024 + (ob ^ (((ob >> 9) & 1) << 5)); }
__device__ __forceinline__ void stage_rc(int b, int& R, int& C) { const int st = b / 1024, sb = b % 1024, swz = sb ^ (((sb >> 9) & 1) << 5); R = (st >> 1) * 16 + swz / 64; C = (st & 1) * 32 + (swz % 64) / 2; }
__device__ __forceinline__ int perm32(int rho) { const int n = rho >> 4, i = rho & 15; return 8 * (i >> 2) + 4 * n + (i & 3); }

enum EpiMode { EPI_STORE = 0, EPI_PG = 1, EPI_GATED = 2, EPI_MIRROR = 3, EPI_SWIGLU = 5, EPI_ROWSCALE = 6 };
struct GemmDesc {
    const char* A; const char* B;
    int lda, ldb, K;
    int nM, nN, nZ;
    long sAz, sAm, sBz, sBn;
    int rz, rm;
    int mode, perm;
    int coff;
    int hook_t;
    const void* gidx;
    void* O; int ldc; long oz;
    const void* P1; const void* P2;
};
struct Unit { unsigned A, B; int row0, col0, z; };

__device__ __forceinline__ bool unit_next(const GemmDesc& d, int i, int G, int c, Unit& u) {
    if (c < 0) return false;
    const int nwg = d.nM * d.nN; const long L = (long)i * G + c;
    if (L >= (long)nwg * d.nZ) return false;
    const int z = (int)(L / nwg); int wgid = (int)(L % nwg);
    { const int q = nwg / NXCD, r = nwg % NXCD, xcd = wgid % NXCD, off = wgid / NXCD; wgid = (xcd < r ? xcd * (q + 1) : r * (q + 1) + (xcd - r) * q) + off; }
    const int nig = WGM * d.nN, gid = wgid / nig, fm = gid * WGM, gsz = (d.nM - fm) < WGM ? (d.nM - fm) : WGM;
    const int pm = fm + ((wgid % nig) % gsz), pn = (wgid % nig) / gsz;
    u.A = (unsigned)((long)z * d.sAz + (long)pm * d.sAm); u.B = (unsigned)((long)z * d.sBz + (long)pn * d.sBn);
    u.row0 = z * d.rz + pm * d.rm; u.col0 = pn * BM; u.z = z; return true;
}

__device__ __forceinline__ void epilogue(const GemmDesc& d, const f32x4 (&acc)[2][2][4][2], const Unit& u, int wr, int wc, int fr, int fq) {
    const int rowb = u.row0 + wr * 64 + fr;
    if (d.mode == EPI_STORE) {
        bf16_t* O = (bf16_t*)d.O + (size_t)u.z * d.oz; const int col0 = u.col0 + wc * 32 + 8 * fq;
#pragma unroll
        for (int ai = 0; ai < 2; ++ai)
#pragma unroll
            for (int m = 0; m < 4; ++m) { bf16_t* rowp = O + (size_t)(rowb + ai * HALF + m * 16) * d.ldc + col0;
#pragma unroll
                for (int bj = 0; bj < 2; ++bj) { const f32x4 v0 = acc[ai][bj][m][0], v1 = acc[ai][bj][m][1];
                    u32x4 w; w.x = cvt_pk_bf16(v0[0], v0[1]); w.y = cvt_pk_bf16(v0[2], v0[3]); w.z = cvt_pk_bf16(v1[0], v1[1]); w.w = cvt_pk_bf16(v1[2], v1[3]);
                    *(u32x4*)(rowp + bj * HALF) = w; } }
    } else if (d.mode == EPI_MIRROR) {
        bf16_t* O = (bf16_t*)d.O; const int col0 = u.col0 + wc * 32 + 8 * fq; const float sgn = d.oz ? -1.0f : 1.0f;
        const int kb = (u.row0 & (SEQ - 1)) + wr * 64 + fr, zb = u.row0 & ~(SEQ - 1);
#pragma unroll
        for (int ai = 0; ai < 2; ++ai)
#pragma unroll
            for (int m = 0; m < 4; ++m) { const int k = kb + ai * HALF + m * 16; bf16_t* rowp = O + (size_t)(zb + k) * UVZ + col0; bf16_t* rowm = O + (size_t)(zb + SEQ - k) * UVZ + col0;
#pragma unroll
                for (int bj = 0; bj < 2; ++bj) { const f32x4 v0 = acc[ai][bj][m][0], v1 = acc[ai][bj][m][1];
                    u32x4 w; w.x = cvt_pk_bf16(v0[0], v0[1]); w.y = cvt_pk_bf16(v0[2], v0[3]); w.z = cvt_pk_bf16(v1[0], v1[1]); w.w = cvt_pk_bf16(v1[2], v1[3]);
                    *(u32x4*)(rowp + bj * HALF) = w;
                    if (k > 0) { u32x4 x; x.x = cvt_pk_bf16(sgn * v0[0], sgn * v0[1]); x.y = cvt_pk_bf16(sgn * v0[2], sgn * v0[3]); x.z = cvt_pk_bf16(sgn * v1[0], sgn * v1[1]); x.w = cvt_pk_bf16(sgn * v1[2], sgn * v1[3]);
                        *(u32x4*)(rowm + bj * HALF) = x; } } }
    } else if (d.mode == EPI_PG) {
        if (d.perm) {
            bf16_t* O = (bf16_t*)d.O; const int col0 = u.col0 + wc * 32 + 8 * fq;
#pragma unroll
            for (int ai = 0; ai < 2; ++ai)
#pragma unroll
                for (int m = 0; m < 4; ++m) { bf16_t* rowp = O + (size_t)(rowb + ai * HALF + m * 16) * FW + col0;
#pragma unroll
                    for (int bj = 0; bj < 2; ++bj) { const f32x4 v0 = acc[ai][bj][m][0], v1 = acc[ai][bj][m][1];
                        u32x4 w; w.x = cvt_pk_bf16(v0[0], v0[1]); w.y = cvt_pk_bf16(v0[2], v0[3]); w.z = cvt_pk_bf16(v1[0], v1[1]); w.w = cvt_pk_bf16(v1[2], v1[3]);
                        *(u32x4*)(rowp + bj * HALF) = w; } }
        } else {
            bf16_t* Rr = (bf16_t*)d.P1; bf16_t* Gp = Rr + (size_t)T * D; const float* bias = (const float*)d.P2;
            const int dc0 = (u.col0 >> 1) + wc * 32 + 8 * fq;
            f32x4 bf[2], bp[2];
#pragma unroll
            for (int bj = 0; bj < 2; ++bj) { bf[bj] = *(const f32x4*)(bias + dc0 + 4 * bj); bp[bj] = *(const f32x4*)(bias + D + dc0 + 4 * bj); }
#pragma unroll
            for (int ai = 0; ai < 2; ++ai)
#pragma unroll
                for (int m = 0; m < 4; ++m) { const size_t off = (size_t)(rowb + ai * HALF + m * 16) * D + dc0; float rr[8], gg[8];
#pragma unroll
                    for (int bj = 0; bj < 2; ++bj) { const f32x4 av = acc[ai][bj][m][0] + bf[bj], bv = acc[ai][bj][m][1] + bp[bj];
#pragma unroll
                        for (int j = 0; j < 4; ++j) { const float ea = __builtin_amdgcn_exp2f(-1.4426950408889634f * fmaxf(av[j], -30.f)), eb = __builtin_amdgcn_exp2f(-1.4426950408889634f * fmaxf(bv[j], -30.f));
                            gg[4 * bj + j] = __builtin_amdgcn_rcpf(1.0f + eb); rr[4 * bj + j] = (1.0f + eb) * __builtin_amdgcn_rcpf(1.0f + ea); } }
                    u32x4 w; w.x = cvt_pk_bf16(rr[0], rr[1]); w.y = cvt_pk_bf16(rr[2], rr[3]); w.z = cvt_pk_bf16(rr[4], rr[5]); w.w = cvt_pk_bf16(rr[6], rr[7]);
                    *(u32x4*)(Rr + off) = w;
                    u32x4 g; g.x = cvt_pk_bf16(gg[0], gg[1]); g.y = cvt_pk_bf16(gg[2], gg[3]); g.z = cvt_pk_bf16(gg[4], gg[5]); g.w = cvt_pk_bf16(gg[6], gg[7]);
                    *(u32x4*)(Gp + off) = g; }
        }
    } else if (d.mode == EPI_GATED) {
        bf16_t* O = (bf16_t*)d.O; const bf16_t* Gm = (const bf16_t*)d.P1; const int col0 = u.col0 + wc * 32 + 8 * fq;
#pragma unroll
        for (int ai = 0; ai < 2; ++ai) { u32x4 g[4][2];
#pragma unroll
            for (int m = 0; m < 4; ++m)
#pragma unroll
                for (int bj = 0; bj < 2; ++bj) g[m][bj] = *(const u32x4*)(Gm + (size_t)(rowb + ai * HALF + m * 16) * D + col0 + bj * HALF);
#pragma unroll
            for (int m = 0; m < 4; ++m) { const size_t r = (size_t)(rowb + ai * HALF + m * 16);
#pragma unroll
                for (int bj = 0; bj < 2; ++bj) { const f32x4 v0 = acc[ai][bj][m][0], v1 = acc[ai][bj][m][1]; const u32x4 q = g[m][bj];
                    u32x4 w; w.x = cvt_pk_bf16(v0[0] * bf_lo(q.x), v0[1] * bf_hi(q.x)); w.y = cvt_pk_bf16(v0[2] * bf_lo(q.y), v0[3] * bf_hi(q.y));
                    w.z = cvt_pk_bf16(v1[0] * bf_lo(q.z), v1[1] * bf_hi(q.z)); w.w = cvt_pk_bf16(v1[2] * bf_lo(q.w), v1[3] * bf_hi(q.w));
                    *(u32x4*)(O + r * D + col0 + bj * HALF) = w; } }
            asm volatile("" ::: "memory"); }
    } else if (d.mode == EPI_SWIGLU) {
        unsigned char* O = (unsigned char*)d.O; const int hc0 = (u.col0 >> 1) + wc * 16 + 4 * fq;
#pragma unroll
        for (int ai = 0; ai < 2; ++ai)
#pragma unroll
            for (int m = 0; m < 4; ++m) { unsigned char* rowp = O + (size_t)(rowb + ai * HALF + m * 16) * HP + hc0;
#pragma unroll
                for (int bj = 0; bj < 2; ++bj) { const f32x4 g = acc[ai][bj][m][0], up = acc[ai][bj][m][1]; float h[4];
#pragma unroll
                    for (int j = 0; j < 4; ++j) h[j] = g[j] * sigmoidf_fast(g[j]) * up[j];
                    int w = 0; w = __builtin_amdgcn_cvt_pk_fp8_f32(h[0], h[1], w, false); w = __builtin_amdgcn_cvt_pk_fp8_f32(h[2], h[3], w, true);
                    *(int*)(rowp + bj * 64) = w; } }
    } else {
        unsigned char* O = (unsigned char*)d.O; const float* gs = (const float*)d.P1; const int col0 = u.col0 + wc * 32 + 8 * fq;
        float scv[2][4];
#pragma unroll
        for (int ai = 0; ai < 2; ++ai)
#pragma unroll
            for (int m = 0; m < 4; ++m) scv[ai][m] = gs[(size_t)(rowb + ai * HALF + m * 16)];
#pragma unroll
        for (int ai = 0; ai < 2; ++ai)
#pragma unroll
            for (int m = 0; m < 4; ++m) { const size_t r = (size_t)(rowb + ai * HALF + m * 16); const float sc = scv[ai][m] * YSC; unsigned char* rowp = O + r * D + col0;
#pragma unroll
                for (int bj = 0; bj < 2; ++bj) { const f32x4 v0 = acc[ai][bj][m][0] * sc, v1 = acc[ai][bj][m][1] * sc; int w0 = 0, w1 = 0;
                    w0 = __builtin_amdgcn_cvt_pk_fp8_f32(v0[0], v0[1], w0, false); w0 = __builtin_amdgcn_cvt_pk_fp8_f32(v0[2], v0[3], w0, true);
                    w1 = __builtin_amdgcn_cvt_pk_fp8_f32(v1[0], v1[1], w1, false); w1 = __builtin_amdgcn_cvt_pk_fp8_f32(v1[2], v1[3], w1, true);
                    u32x2 w; w.x = (unsigned)w0; w.y = (unsigned)w1; *(u32x2*)(rowp + bj * HALF) = w; } }
    }
}

__device__ __forceinline__ void midk_scale(const GemmDesc& d, f32x4 (&acc)[2][2][4][2], const Unit& u, int wr, int wc, int fr, int fq) {
    typedef __attribute__((address_space(1))) const bf16_t* gptr;
    gptr p0 = (gptr)((const bf16_t*)d.P2 + (size_t)(u.row0 + wr * 64 + fr) * D + (u.col0 + wc * 32 + 8 * fq));
    asm volatile("" : "+v"(p0));
#pragma unroll
    for (int ai = 0; ai < 2; ++ai) { u32x4 g[4][2];
#pragma unroll
        for (int m = 0; m < 4; ++m)
#pragma unroll
            for (int bj = 0; bj < 2; ++bj) g[m][bj] = *(const __attribute__((address_space(1))) u32x4*)(p0 + (size_t)(ai * HALF + m * 16) * D + bj * HALF);
#pragma unroll
        for (int m = 0; m < 4; ++m)
#pragma unroll
            for (int bj = 0; bj < 2; ++bj) { const u32x4 q = g[m][bj]; f32x4& v0 = acc[ai][bj][m][0]; f32x4& v1 = acc[ai][bj][m][1];
                v0[0] *= bf_lo(q.x); v0[1] *= bf_hi(q.x); v0[2] *= bf_lo(q.y); v0[3] *= bf_hi(q.y); v1[0] *= bf_lo(q.z); v1[1] *= bf_hi(q.z); v1[2] *= bf_lo(q.w); v1[3] *= bf_hi(q.w); }
        asm volatile("" ::: "memory"); }
}

__device__ __forceinline__ void tile_prefetch(const void* base, int row0, int col0, LAS unsigned char* lds, int tid, int wid) {
    const char* p = (const char*)base + ((size_t)(row0 + (tid >> 1)) * D + col0) * 2 + (tid & 1) * 256;
    asm volatile("" : "+v"(p));
    LAS unsigned* dst = (LAS unsigned*)(lds + 131072 + wid * 512);
    __builtin_amdgcn_global_load_lds((const unsigned*)p, dst, 4, 0, 0);
    __builtin_amdgcn_global_load_lds((const unsigned*)(p + 128), dst + 64, 4, 0, 0);
}

template <bool GATHER, bool HOOK, bool FP8>
__device__ __forceinline__ void gemm_run(LAS unsigned char* lds, const GemmDesc& d, int G, int cblk, const int tid) {
    const int wid = __builtin_amdgcn_readfirstlane(tid >> 6), lane = tid & 63, wr = wid >> 2, wc = wid & 3, fr = lane & 15, fq = lane >> 4;
    const int nt = d.K / BK; const int c = cblk - d.coff;
    unsigned voffA[2], voffB[2];
#pragma unroll
    for (int i = 0; i < 2; ++i) { int R, C; stage_rc(tid * 16 + i * 8192, R, C); const int Rb = d.perm ? ((R & ~31) + perm32(R & 31)) : R;
        voffA[i] = (unsigned)(R * d.lda + C) * 2u; voffB[i] = (unsigned)(Rb * d.ldb + C) * 2u; }
    const unsigned kstep = BK * 2;
    const unsigned hstepA = (unsigned)HALF * d.lda * 2, hstepB = (unsigned)HALF * d.ldb * 2;
    const unsigned ldsw = (unsigned)wid * 1024u;
    const int aoff = lds_byte(wr * 64 + fr, fq * 8), boff = lds_byte(wc * 32 + fr, fq * 8);
#define PG8_SA(b, h) (((b) * 2 + (h)) * HTB)
#define PG8_SB(b, h) ((4 + (b) * 2 + (h)) * HTB)
#define PG8_LDA(dst, b, h) do { _Pragma("unroll") for (int m = 0; m < 4; ++m) _Pragma("unroll") for (int k = 0; k < 2; ++k) dst[m][k] = *(const LAS bf16x8*)(lds + PG8_SA(b, h) + aoff + m * 2048 + k * 1024); } while (0)
#define PG8_LDB(dst, b, h) do { _Pragma("unroll") for (int n = 0; n < 2; ++n) _Pragma("unroll") for (int k = 0; k < 2; ++k) dst[n][k] = *(const LAS bf16x8*)(lds + PG8_SB(b, h) + boff + n * 2048 + k * 1024); } while (0)
    int fscale = 124; asm volatile("" : "+v"(fscale));
#define PG8_MMA(ai, bj, At, Bt) do { __builtin_amdgcn_s_setprio(1); _Pragma("unroll") for (int m = 0; m < 4; ++m) _Pragma("unroll") for (int n = 0; n < 2; ++n) { \
        if constexpr (FP8) { const i32x8 b8_ = __builtin_shufflevector(__builtin_bit_cast(i32x4, Bt[n][0]), __builtin_bit_cast(i32x4, Bt[n][1]), 0, 1, 2, 3, 4, 5, 6, 7), \
                a8_ = __builtin_shufflevector(__builtin_bit_cast(i32x4, At[m][0]), __builtin_bit_cast(i32x4, At[m][1]), 0, 1, 2, 3, 4, 5, 6, 7); \
            asm volatile("v_mfma_scale_f32_16x16x128_f8f6f4 %0, %1, %2, %0, %3, %3 op_sel_hi:[0,0,0]" : "+v"(acc[ai][bj][m][n]) : "v"(b8_), "v"(a8_), "v"(fscale)); } \
        else { _Pragma("unroll") for (int k = 0; k < 2; ++k) acc[ai][bj][m][n] = __builtin_amdgcn_mfma_f32_16x16x32_bf16(Bt[n][k], At[m][k], acc[ai][bj][m][n], 0, 0, 0); } } \
        __builtin_amdgcn_s_setprio(0); } while (0)
#define PG8_WAIT_V(n) asm volatile("s_waitcnt vmcnt(" #n ")" ::: "memory")
#define PG8_WAIT_L(n) asm volatile("s_waitcnt lgkmcnt(" #n ")" ::: "memory")
#define PG8_BAR __builtin_amdgcn_s_barrier()
#define PG8_SCHED __builtin_amdgcn_sched_barrier(0)
    const unsigned stash = 131072u + (unsigned)tid * 32u; int cs = 0;
#define PG8_GATHER_OFFS(slot_, row0_) do { int gi_[2][2]; \
        _Pragma("unroll") for (int h_ = 0; h_ < 2; ++h_) _Pragma("unroll") for (int i_ = 0; i_ < 2; ++i_) { int R_, C_; stage_rc(tid * 16 + i_ * 8192, R_, C_); gi_[h_][i_] = ((const int*)d.gidx)[(row0_) + h_ * HALF + R_]; } \
        asm volatile("s_waitcnt vmcnt(0)" ::: "memory"); u32x4 o_; \
        { int R_, C_; stage_rc(tid * 16, R_, C_); o_.x = (unsigned)(gi_[0][0] * d.lda + C_) * 2u; o_.z = (unsigned)(gi_[1][0] * d.lda + C_) * 2u; } \
        { int R_, C_; stage_rc(tid * 16 + 8192, R_, C_); o_.y = (unsigned)(gi_[0][1] * d.lda + C_) * 2u; o_.w = (unsigned)(gi_[1][1] * d.lda + C_) * 2u; } \
        *(LAS u32x4*)(lds + stash + (slot_) * 16) = o_; } while (0)
#define PG8_STAGE(bufoff, rsrc, soff, voff) do { _Pragma("unroll") for (int _i = 0; _i < 2; ++_i) \
        __builtin_amdgcn_raw_ptr_buffer_load_lds(rsrc, (LAS unsigned*)(lds + (bufoff) + ldsw + _i * 8192), 16, (voff)[_i], (soff), 0, 0); } while (0)
#define PG8_STAGE_G(bufoff, soff, slot_, h_) do { const u32x2 o_ = *(const LAS u32x2*)(lds + stash + (slot_) * 16 + (h_) * 8); \
        __builtin_amdgcn_raw_ptr_buffer_load_lds(rsrcA, (LAS unsigned*)(lds + (bufoff) + ldsw), 16, o_.x, (soff), 0, 0); \
        __builtin_amdgcn_raw_ptr_buffer_load_lds(rsrcA, (LAS unsigned*)(lds + (bufoff) + ldsw + 8192), 16, o_.y, (soff), 0, 0); } while (0)
#define PG8_STAGE_A(bufoff, soff, slot_, h_) do { if constexpr (GATHER) PG8_STAGE_G(bufoff, soff, slot_, h_); else PG8_STAGE(bufoff, rsrcA, (soff) + (h_) * hstepA, voffA); } while (0)
#define PG8_STAGE_B(bufoff, soff) PG8_STAGE(bufoff, rsrcB, soff, voffB)
    const __amdgpu_buffer_rsrc_t rsrcA = __builtin_amdgcn_make_buffer_rsrc((void*)d.A, 0, 0x7fffffff, 0x00020000), rsrcB = __builtin_amdgcn_make_buffer_rsrc((void*)d.B, 0, 0x7fffffff, 0x00020000);
    Unit cur, nxt; int ui = 0;
    if (!unit_next(d, 0, G, c, cur)) return;
    f32x4 acc[2][2][4][2];
#pragma unroll
    for (int a = 0; a < 2; ++a)
#pragma unroll
        for (int b = 0; b < 2; ++b)
#pragma unroll
            for (int m = 0; m < 4; ++m)
#pragma unroll
                for (int n = 0; n < 2; ++n) acc[a][b][m][n] = (f32x4){0.f, 0.f, 0.f, 0.f};
    bf16x8 At[4][2], B0[2][2], B1[2][2];
    unsigned cA = cur.A, cB = cur.B;
    if constexpr (GATHER) PG8_GATHER_OFFS(cs, cur.row0);
    PG8_STAGE_B(PG8_SB(0, 0), cB); PG8_STAGE_B(PG8_SB(0, 1), cB + hstepB); PG8_STAGE_A(PG8_SA(0, 0), cA, cs, 0); PG8_STAGE_A(PG8_SA(0, 1), cA, cs, 1);
    if (wr == 1) PG8_BAR;
    PG8_WAIT_V(2); PG8_BAR;
    PG8_STAGE_B(PG8_SB(1, 0), cB + kstep); PG8_STAGE_A(PG8_SA(1, 0), cA + kstep, cs, 0); PG8_STAGE_B(PG8_SB(1, 1), cB + hstepB + kstep);
    PG8_WAIT_V(6); PG8_BAR;
    for (;;) {
        const bool has_next = unit_next(d, ui + 1, G, c, nxt);
        const unsigned nA = has_next ? nxt.A : cA, nB = has_next ? nxt.B : cB;
        if constexpr (GATHER) { if (has_next) PG8_GATHER_OFFS(cs ^ 1, nxt.row0); else { const u32x4 o_ = *(const LAS u32x4*)(lds + stash + cs * 16); *(LAS u32x4*)(lds + stash + (cs ^ 1) * 16) = o_; } }
        for (int t = 0; t < nt; t += 2) {
            const bool last = (t == nt - 2);
            const unsigned a1 = cA + (unsigned)(t + 1) * kstep;
            const unsigned a2 = last ? nA : cA + (unsigned)(t + 2) * kstep, b2 = last ? nB : cB + (unsigned)(t + 2) * kstep;
            const unsigned a3 = a2 + kstep, b3 = b2 + kstep;
            const int ns = last ? (cs ^ 1) : cs;
            if constexpr (HOOK) { if (d.hook_t == t) { midk_scale(d, acc, cur, wr, wc, fr, fq); } }
            PG8_LDB(B0, 0, 0); PG8_LDB(B1, 0, 1); PG8_SCHED; PG8_LDA(At, 0, 0); PG8_STAGE_A(PG8_SA(1, 1), a1, cs, 1);
            PG8_WAIT_V(8); PG8_WAIT_L(0); PG8_BAR; PG8_MMA(0, 0, At, B0); PG8_MMA(0, 1, At, B1); PG8_BAR; PG8_SCHED;
            PG8_LDA(At, 0, 1); PG8_STAGE_B(PG8_SB(0, 0), b2); PG8_STAGE_B(PG8_SB(0, 1), b2 + hstepB); PG8_STAGE_A(PG8_SA(0, 0), a2, ns, 0);
            PG8_WAIT_V(8); PG8_WAIT_L(0); PG8_BAR; PG8_MMA(1, 0, At, B0); PG8_MMA(1, 1, At, B1); PG8_BAR; PG8_SCHED;
            PG8_LDB(B0, 1, 0); PG8_LDB(B1, 1, 1); PG8_SCHED; PG8_LDA(At, 1, 0); PG8_STAGE_A(PG8_SA(0, 1), a2, ns, 1);
            PG8_WAIT_V(8); PG8_WAIT_L(0); PG8_BAR; PG8_MMA(0, 0, At, B0); PG8_MMA(0, 1, At, B1); PG8_BAR; PG8_SCHED;
            PG8_LDA(At, 1, 1); PG8_STAGE_B(PG8_SB(1, 0), b3); PG8_STAGE_B(PG8_SB(1, 1), b3 + hstepB); PG8_STAGE_A(PG8_SA(1, 0), a3, ns, 0);
            PG8_WAIT_V(8); PG8_WAIT_L(0); PG8_BAR; PG8_MMA(1, 0, At, B0); PG8_MMA(1, 1, At, B1); PG8_BAR; PG8_SCHED;
        }
        if (wr == 0) PG8_BAR;
        if constexpr (FP8) asm volatile("s_nop 15\n\ts_nop 15" ::: "memory");
        epilogue(d, acc, cur, wr, wc, fr, fq);
        if (!has_next) break;
#pragma unroll
        for (int a = 0; a < 2; ++a)
#pragma unroll
            for (int b = 0; b < 2; ++b)
#pragma unroll
                for (int m = 0; m < 4; ++m)
#pragma unroll
                    for (int n = 0; n < 2; ++n) acc[a][b][m][n] = (f32x4){0.f, 0.f, 0.f, 0.f};
        cur = nxt; cA = nA; cB = nB; ++ui;
        if constexpr (GATHER) cs ^= 1;
        if (wr == 1) PG8_BAR;
    }
    PG8_WAIT_V(0);
    PG8_BAR;
#undef PG8_SA
#undef PG8_SB
#undef PG8_STAGE
#undef PG8_LDA
#undef PG8_LDB
#undef PG8_MMA
#undef PG8_WAIT_V
#undef PG8_WAIT_L
#undef PG8_BAR
#undef PG8_SCHED
#undef PG8_GATHER_OFFS
#undef PG8_STAGE_G
#undef PG8_STAGE_A
#undef PG8_STAGE_B
}

struct Args { const float* in[17]; float* out; unsigned char* ws; int ph_lo, ph_hi; };
enum In { I_X = 0, I_NMIX, I_WIN, I_WFM, I_WPM, I_PSCALE, I_WBF, I_WBP, I_WGATE, I_BGATE, I_WOUT, I_NMOE, I_WROUTER, I_WEG, I_WEU, I_WED, I_NFINAL };

enum GemmId { G_MGU = 0, G_MGV, G_MGP, G_1A, G_1B, G_1C, G_DFTU, G_DFTV, G_4, G_OUT, G_GU, G_DOWN };
__device__ __forceinline__ void make_desc(int id, const Args& a, GemmDesc& d) {
    unsigned char* ws = a.ws;
    d.sAz = 0; d.sBz = 0; d.rz = 0; d.rm = BM; d.nZ = 1; d.coff = 0; d.oz = 0; d.P1 = nullptr; d.P2 = nullptr; d.perm = 1; d.mode = EPI_STORE; d.hook_t = -1; d.gidx = nullptr;
    switch (id) {
    case G_MGU:
    case G_MGV:
    case G_MGP:
        d.A = (const char*)(ws + (id == G_MGP ? WS_WBPT : WS_WBFT)); d.lda = FW; d.B = (const char*)(ws + (id == G_MGU ? WS_MIXC : id == G_MGV ? WS_MIXS : WS_MIXP)); d.ldb = 256; d.K = 256; d.nM = 8; d.nN = 1; d.nZ = 4;
        d.sAz = 256 * 2; d.sAm = (long)BM * FW * 2; d.sBz = 256 * 256 * 2; d.sBn = 0; d.O = ws + WS_WUVP + (size_t)(id - G_MGU) * FW * 2; d.ldc = UVZ; d.oz = 256; d.coff = 32 * (id - G_MGU); break;
    case G_1A:
        d.A = (const char*)(ws + WS_WTIN); d.lda = D; d.B = (const char*)(ws + WS_RA); d.ldb = D; d.K = D; d.nM = 4; d.nN = 8; d.nZ = 8;
        d.sAm = (long)BM * D * 2; d.sBz = (long)SEQ * D * 2; d.sBn = (long)BM * D * 2; d.O = ws + WS_RB; d.ldc = SEQ; d.oz = (long)FW * SEQ; break;
    case G_1B:
        d.A = (const char*)(ws + WS_RA); d.lda = D; d.B = (const char*)(ws + WS_WTIN + (size_t)FW * D * 2); d.ldb = D; d.K = D; d.nM = T / BM; d.nN = 4;
        d.sAm = (long)BM * D * 2; d.sBn = (long)BM * D * 2; d.mode = EPI_PG; d.perm = 1; d.O = ws + WS_RC; d.ldc = FW; d.P1 = ws + WS_RD; d.P2 = a.in[I_BGATE]; break;
    case G_1C:
        d.A = (const char*)(ws + WS_RE); d.lda = D / 2; d.B = (const char*)(ws + WS_WTG); d.ldb = D / 2; d.K = D / 2; d.nM = T / BM; d.nN = 16;
        d.sAm = (long)BM * D; d.sBn = (long)BM * D; d.mode = EPI_PG; d.perm = 0; d.O = ws + WS_RC; d.ldc = FW; d.P1 = ws + WS_RD; d.P2 = a.in[I_BGATE]; break;
    case G_DFTU:
    case G_DFTV:
        { const int ku = (id == G_DFTU ? KU : FW);
        d.A = (const char*)(ws + (id == G_DFTU ? WS_TC : WS_TS)); d.lda = ku; d.B = (const char*)(ws + (id == G_DFTU ? WS_PP : WS_PM)); d.ldb = ku; d.K = ku; d.nM = 4; d.nN = 4; d.nZ = 8;
        d.sAm = (long)BM * ku * 2; d.sBz = (long)FW * ku * 2; d.sBn = (long)BM * ku * 2; d.rz = SEQ; d.mode = EPI_MIRROR; d.O = ws + WS_RE + (id == G_DFTV ? FW * 2 : 0); d.ldc = UVZ; d.oz = (id == G_DFTV); d.coff = (id == G_DFTV ? 128 : 0); }
        break;
    case G_4:
        d.A = (const char*)(ws + WS_RE); d.lda = UVZ; d.B = (const char*)(ws + WS_WUVP); d.ldb = UVZ; d.K = KUVZ; d.nM = T / BM; d.nN = 8;
        d.sAm = (long)BM * UVZ * 2; d.sBn = (long)BM * UVZ * 2; d.mode = EPI_GATED; d.O = ws + WS_RA; d.ldc = D; d.hook_t = (2 * FW / BK);
        d.P1 = ws + WS_RD + (size_t)T * D * 2; d.P2 = ws + WS_RD; break;
    case G_OUT:
        d.A = (const char*)(ws + WS_RA); d.lda = D; d.B = (const char*)(ws + WS_WOUT); d.ldb = D; d.K = D; d.nM = T / BM; d.nN = 8;
        d.sAm = (long)BM * D * 2; d.sBn = (long)BM * D * 2; d.mode = EPI_STORE; d.O = a.out; d.ldc = 2 * D; break;
    case G_GU:
        d.A = (const char*)(ws + WS_RA); d.lda = D / 2; d.B = (const char*)(ws + WS_WGU); d.ldb = D / 2; d.K = D / 2; d.nM = BATCH; d.nN = 11; d.nZ = NE;
        d.sAz = 0; d.sAm = (long)SEQ * D; d.sBz = (long)2 * FF * D; d.sBn = (long)BM * D; d.rz = BM; d.rm = NE * BM;
        d.mode = EPI_SWIGLU; d.perm = 0; d.O = ws + WS_RB; d.ldc = FF; d.gidx = ws + WS_IDX; break;
    default:
        d.A = (const char*)(ws + WS_RB); d.lda = HP / 2; d.B = (const char*)(ws + WS_WD); d.ldb = HP / 2; d.K = HP / 2; d.nM = BATCH; d.nN = 8; d.nZ = NE;
        d.sAz = (long)BM * HP; d.sAm = (long)NE * BM * HP; d.sBz = (long)D * HP; d.sBn = (long)BM * HP; d.rz = BM; d.rm = NE * BM;
        d.mode = EPI_ROWSCALE; d.O = ws + WS_RD; d.ldc = D; d.P1 = ws + WS_GATE; break;
    }
}

__device__ __forceinline__ void transpose_tile(const float* src, int ldw, bf16_t* dbase, int ldt, int il, LAS float* scr, int lane) {
    (void)scr; (void)il;
    f32x4 v[16]; const int kb = lane >> 4, n4 = 4 * (lane & 15);
#pragma unroll
    for (int j = 0; j < 16; ++j) v[j] = __builtin_nontemporal_load((const f32x4*)(src + (size_t)(16 * kb + j) * ldw + n4));
#pragma unroll
    for (int i = 0; i < 4; ++i) { u32x4 o0, o1;
        o0.x = cvt_pk_bf16(v[0][i], v[1][i]); o0.y = cvt_pk_bf16(v[2][i], v[3][i]); o0.z = cvt_pk_bf16(v[4][i], v[5][i]); o0.w = cvt_pk_bf16(v[6][i], v[7][i]);
        o1.x = cvt_pk_bf16(v[8][i], v[9][i]); o1.y = cvt_pk_bf16(v[10][i], v[11][i]); o1.z = cvt_pk_bf16(v[12][i], v[13][i]); o1.w = cvt_pk_bf16(v[14][i], v[15][i]);
        bf16_t* rp = dbase + (size_t)(n4 + i) * ldt + 16 * kb; *(u32x4*)rp = o0; *(u32x4*)(rp + 8) = o1; }
}

__device__ __forceinline__ void transpose_tile_f8(const float* src, int ldw, unsigned char* dmat, int ldt, int n0, int il, int up16, float scale, LAS float* scr, int lane) {
    (void)scr;
    f32x4 v[16]; const int kb = lane >> 3, n4 = 4 * (lane & 7);
#pragma unroll
    for (int j = 0; j < 16; ++j) v[j] = __builtin_nontemporal_load((const f32x4*)(src + (size_t)(16 * kb + j) * ldw + n4));
#pragma unroll
    for (int i = 0; i < 4; ++i) { i32x4 o;
#pragma unroll
        for (int q = 0; q < 4; ++q) { int w = 0; w = __builtin_amdgcn_cvt_pk_fp8_f32(v[4 * q][i] * scale, v[4 * q + 1][i] * scale, w, false); w = __builtin_amdgcn_cvt_pk_fp8_f32(v[4 * q + 2][i] * scale, v[4 * q + 3][i] * scale, w, true); o[q] = w; }
        const int hn = n0 + n4 + i; const int dd_ = hn & 127;
        const int ro = il == 1 ? ((hn >> 7) * 256 + ((hn >> 6) & 1) * 128 + ((hn >> 4) & 3) * 32 + (hn & 15) + up16)
                     : il == 2 ? (((hn & 2047) >> 7) * 256 + 128 * ((dd_ >> 2) & 1) + 32 * (dd_ >> 5) + 16 * (hn >> 11) + 4 * ((dd_ >> 3) & 3) + (dd_ & 3)) : hn;
        *(i32x4*)(dmat + (size_t)ro * ldt + 16 * kb) = o; }
}

__device__ __forceinline__ void p0_items(const Args& a, LAS unsigned char* lds, int gw, int NGW, int wave, int lane, int it_lo, int it_hi) {
    unsigned char* ws = a.ws;
    LAS float* scr = (LAS float*)(lds + wave * (64 * 68 * 4));
    constexpr int I0 = 1024, I1 = 2048, I2 = 512, I3 = 512, I4 = 1024, IE = 16 * 704;
    constexpr int NITEMS = I0 + I1 + I2 + I3 + I4 + 3 * IE;
    (void)NITEMS;
    for (int it = it_lo + gw; it < it_hi; it += NGW) {
        int r = it; const float* src; int ldw, ldt, il = 0; bf16_t* db;
        if (r < I0) { const int kb = r / 32, nb = r % 32; src = a.in[I_WIN] + (size_t)(64 * kb) * D + 64 * nb; ldw = D; ldt = D; db = (bf16_t*)(ws + WS_WTIN) + (size_t)(64 * nb) * D + 64 * kb; }
        else if ((r -= I0) < I1) { const int kb = r / 128, nb = r % 128;
            transpose_tile_f8(a.in[I_WGATE] + (size_t)(128 * kb) * (2 * D) + 32 * nb, 2 * D, ws + WS_WTG + 128 * kb, D, 32 * nb, 2, 0, 64.0f, scr, lane); continue; }
        else if ((r -= I1) < I2) { const int kb = r / 32, nb = r % 32; src = a.in[I_WBF] + (size_t)(64 * kb) * D + 64 * nb; ldw = D; ldt = FW; db = (bf16_t*)(ws + WS_WBFT) + (size_t)(64 * nb) * FW + 64 * kb; }
        else if ((r -= I2) < I3) { const int kb = r / 32, nb = r % 32; src = a.in[I_WBP] + (size_t)(64 * kb) * D + 64 * nb; ldw = D; ldt = FW; db = (bf16_t*)(ws + WS_WBPT) + (size_t)(64 * nb) * FW + 64 * kb; }
        else if ((r -= I3) < I4) { const int kb = r / 32, nb = r % 32; src = a.in[I_WOUT] + (size_t)(64 * kb) * D + 64 * nb; ldw = D; ldt = D; db = (bf16_t*)(ws + WS_WOUT) + (size_t)(64 * nb) * D + 64 * kb; }
        else if ((r -= I4) < 2 * IE) { const int up = r >= IE; if (up) r -= IE; const int e = r / 704, q = r % 704, kb = q / 44, nb = q % 44;
            src = (up ? a.in[I_WEU] : a.in[I_WEG]) + (size_t)e * D * FF + (size_t)(128 * kb) * FF + 32 * nb;
            transpose_tile_f8(src, FF, ws + WS_WGU + (size_t)e * 2 * FF * D + 128 * kb, D, 32 * nb, 1, 16 * up, 64.0f, scr, lane); continue; }
        else { r -= 2 * IE; const int e = r / 704, q = r % 704, kb = q / 64, nb = q % 64;
            transpose_tile_f8(a.in[I_WED] + (size_t)e * FF * D + (size_t)(128 * kb) * D + 32 * nb, D, ws + WS_WD + (size_t)e * D * HP + 128 * kb, HP, 32 * nb, 0, 0, 64.0f, scr, lane); continue; }
        transpose_tile(src, ldw, db, ldt, il, scr, lane);
    }
}
constexpr int P0_NBASE = 1024 + 2048 + 512 + 512, P0_NITEMS = P0_NBASE + 1024 + 3 * 16 * 704;
__device__ __forceinline__ void p0_prologue(const Args& a, LAS unsigned char* lds, int gw, int NGW, int wave, int lane) {
    unsigned char* ws = a.ws;
    p0_items(a, lds, gw, NGW, wave, lane, 0, P0_NBASE);
    const int gt = gw * 64 + lane, NGT = NGW * 64;
    for (int i = gt; i < FW * 256 / 4; i += NGT) { const f32x4 v = *(const f32x4*)(a.in[I_WPM] + 4 * (size_t)i);
        const int g = i / (256 * 64), c2 = (i % 64) * 4; const f32x4 sc = *(const f32x4*)(a.in[I_PSCALE] + g * 256 + c2);
        u32x2 o; o.x = pk2(v[0] * sc[0], v[1] * sc[1]); o.y = pk2(v[2] * sc[2], v[3] * sc[3]); *(u32x2*)((bf16_t*)(ws + WS_MIXP) + 4 * (size_t)i) = o; }
    { LAS float* ct = (LAS float*)(lds + 147456);
        for (int i = lane + 64 * wave; i < 256; i += 64 * NWAVES) ct[i] = cospif((float)i * (1.0f / 128.0f));
        LDS_WAIT(); __syncthreads();
        for (int i = gt; i < 4 * 256 * 64; i += NGT) { const int c2 = (i & 63) * 4, cp = (i >> 6) & 255, g = i >> 14; const float* w = a.in[I_WFM] + (size_t)g * 65536 + c2;
            f32x4 sc_ = {0.f, 0.f, 0.f, 0.f}, ss_ = {0.f, 0.f, 0.f, 0.f};
#pragma unroll 8
            for (int c = 0; c < 256; ++c) { const f32x4 wv = *(const f32x4*)(w + (size_t)c * 256); const int ph = (c * cp) & 255; sc_ += wv * ct[ph]; ss_ += wv * ct[(ph - 64) & 255]; }
            const size_t o = (size_t)g * 65536 + (size_t)cp * 256 + c2;
            u32x2 oc; oc.x = pk2(sc_[0] * 0.0625f, sc_[1] * 0.0625f); oc.y = pk2(sc_[2] * 0.0625f, sc_[3] * 0.0625f); *(u32x2*)((bf16_t*)(ws + WS_MIXC) + o) = oc;
            u32x2 os; os.x = pk2(-ss_[0] * 0.0625f, -ss_[1] * 0.0625f); os.y = pk2(-ss_[2] * 0.0625f, -ss_[3] * 0.0625f); *(u32x2*)((bf16_t*)(ws + WS_MIXS) + o) = os; } }
    for (int i = gt; i < NE * D * 8; i += NGT) *(i32x4*)(ws + WS_WD + (size_t)(i >> 3) * HP + FF + 16 * (i & 7)) = (i32x4){0, 0, 0, 0};
    for (int i = gt; i < FW * KU / 2; i += NGT) { const int k = i / (KU / 2), n = (i % (KU / 2)) * 2; float o2[2];
#pragma unroll
        for (int q = 0; q < 2; ++q) { const int ph = (k * (n + q)) & (SEQ - 1); o2[q] = (n + q <= FW) ? cospif((float)ph * (1.0f / 1024.0f)) * 0.02209708691207961f : 0.f; }
        *(unsigned*)((bf16_t*)(ws + WS_TC) + (size_t)k * KU + n) = pk2(o2[0], o2[1]); }
    for (int i = gt; i < FW * FW / 2; i += NGT) { const int k = i / (FW / 2), n = (i % (FW / 2)) * 2; float o2[2];
#pragma unroll
        for (int q = 0; q < 2; ++q) { const int ph = (k * (n + q)) & (SEQ - 1); o2[q] = sinpif((float)ph * (1.0f / 1024.0f)) * 0.02209708691207961f; }
        *(unsigned*)((bf16_t*)(ws + WS_TS) + (size_t)k * FW + n) = pk2(o2[0], o2[1]); }
    const float* gm = a.in[I_NMIX];
    for (int m = gw; m < T; m += NGW) { const f32x4* xr = (const f32x4*)(a.in[I_X] + (size_t)m * D) + lane; f32x4 v[8]; float s = 0.f;
#pragma unroll
        for (int j = 0; j < 8; ++j) { v[j] = __builtin_nontemporal_load(xr + 64 * j); s += (v[j][0] * v[j][0] + v[j][1] * v[j][1]) + (v[j][2] * v[j][2] + v[j][3] * v[j][3]); }
        const float rstd = 1.0f / sqrtf(wave_sum(s) * (1.0f / D) + EPS);
        u32x2* o8 = (u32x2*)((bf16_t*)(ws + WS_RA) + (size_t)m * D) + lane; unsigned* o4 = (unsigned*)(ws + WS_RE + (size_t)m * D) + lane;
#pragma unroll
        for (int j = 0; j < 8; ++j) { const f32x4 g = ((const f32x4*)gm)[lane + 64 * j]; const f32x4 uv = v[j] * g * rstd; u32x2 o; o.x = pk2(uv[0], uv[1]); o.y = pk2(uv[2], uv[3]); o8[64 * j] = o;
            int w = 0; w = __builtin_amdgcn_cvt_pk_fp8_f32(uv[0], uv[1], w, false); w = __builtin_amdgcn_cvt_pk_fp8_f32(uv[2], uv[3], w, true); o4[64 * j] = (unsigned)w; } }
}

__device__ __forceinline__ void p3_fold(const Args& a, int gw, int NGW, int lane) {
    const bf16_t* PT = (const bf16_t*)(a.ws + WS_RB); bf16_t* PP = (bf16_t*)(a.ws + WS_PP); bf16_t* PM = (bf16_t*)(a.ws + WS_PM); bf16_t* Z = (bf16_t*)(a.ws + WS_RE);
    for (int row = gw; row < BATCH * FW; row += NGW) { const bf16_t* p = PT + (size_t)row * SEQ;
        u32x4 X[2], M[2]; unsigned E[2];
#pragma unroll
        for (int j = 0; j < 2; ++j) { const int n0 = 8 * lane + 512 * j; X[j] = *(const u32x4*)(p + n0); M[j] = *(const u32x4*)(p + 2040 - n0); E[j] = (n0 > 0) ? (unsigned)p[SEQ - n0] : 0u; }
        const float xm = bf_lo((unsigned)p[FW]); float alt = 0.f;
#pragma unroll
        for (int j = 0; j < 2; ++j) { const int n0 = 8 * lane + 512 * j;
            float x[8], m[8], y[8]; x[0] = bf_lo(X[j].x); x[1] = bf_hi(X[j].x); x[2] = bf_lo(X[j].y); x[3] = bf_hi(X[j].y); x[4] = bf_lo(X[j].z); x[5] = bf_hi(X[j].z); x[6] = bf_lo(X[j].w); x[7] = bf_hi(X[j].w);
            m[0] = bf_lo(M[j].x); m[1] = bf_hi(M[j].x); m[2] = bf_lo(M[j].y); m[3] = bf_hi(M[j].y); m[4] = bf_lo(M[j].z); m[5] = bf_hi(M[j].z); m[6] = bf_lo(M[j].w); m[7] = bf_hi(M[j].w);
            y[0] = bf_lo(E[j]);
#pragma unroll
            for (int i = 1; i < 8; ++i) y[i] = m[8 - i];
            float sp[8], sm[8];
#pragma unroll
            for (int i = 0; i < 8; ++i) { sp[i] = x[i] + y[i]; sm[i] = x[i] - y[i]; alt += (i & 1) ? -sp[i] : sp[i]; }
            if (n0 == 0) sm[0] = 0.f;
            u32x4 wp, wm; wp.x = pk2(sp[0], sp[1]); wp.y = pk2(sp[2], sp[3]); wp.z = pk2(sp[4], sp[5]); wp.w = pk2(sp[6], sp[7]); wm.x = pk2(sm[0], sm[1]); wm.y = pk2(sm[2], sm[3]); wm.z = pk2(sm[4], sm[5]); wm.w = pk2(sm[6], sm[7]);
            *(u32x4*)(PP + (size_t)row * KU + n0) = wp; *(u32x4*)(PM + (size_t)row * FW + n0) = wm; }
        if (lane < 16) { u32x4 t = {0u, 0u, 0u, 0u}; if (lane == 0) t.x = f2bf(xm); *(u32x4*)(PP + (size_t)row * KU + FW + 8 * lane) = t; }
        alt = wave_sum(alt) + xm;
        if (lane == 0) { const int b = row >> 10, c = row & (FW - 1); Z[(size_t)(b * SEQ + FW) * UVZ + c] = (bf16_t)f2bf(alt * 0.02209708691207961f); Z[(size_t)(b * SEQ + FW) * UVZ + FW + c] = 0; } }
}

__device__ __forceinline__ void ld8(const bf16_t* p, float (&f)[8]) { const u32x4 w = *(const u32x4*)p; f[0] = bf_lo(w.x); f[1] = bf_hi(w.x); f[2] = bf_lo(w.y); f[3] = bf_hi(w.y); f[4] = bf_lo(w.z); f[5] = bf_hi(w.z); f[6] = bf_lo(w.w); f[7] = bf_hi(w.w); }
__device__ __forceinline__ void p3_pool(const Args& a, int gtid, int NGT) {
    const bf16_t* P = (const bf16_t*)(a.ws + WS_RC); bf16_t* Z = (bf16_t*)(a.ws + WS_RE);
    for (int idx = gtid; idx < BATCH * 128 * 128; idx += NGT) {
        const int cb = idx & 127, chunk = (idx >> 7) & 127, b = idx >> 14, half = 1 << (cb >> 5), i0 = chunk * 16;
        const bf16_t* Pb = P + (size_t)b * SEQ * FW + cb * 8;
        float sum[8];
#pragma unroll
        for (int q = 0; q < 8; ++q) sum[q] = 0.f;
        { u32x4 w[16];
#pragma unroll
          for (int k = 0; k < 16; ++k) { int r = i0 - half + k; r = r < 0 ? 0 : (r > SEQ - 1 ? SEQ - 1 : r); w[k] = *(const u32x4*)(Pb + (size_t)r * FW); }
#pragma unroll
          for (int k = 0; k < 16; ++k) { const int r = i0 - half + k; const float mk = (k < 2 * half && r >= 0 && r < SEQ) ? 1.f : 0.f;
              sum[0] += mk * bf_lo(w[k].x); sum[1] += mk * bf_hi(w[k].x); sum[2] += mk * bf_lo(w[k].y); sum[3] += mk * bf_hi(w[k].y); sum[4] += mk * bf_lo(w[k].z); sum[5] += mk * bf_hi(w[k].z); sum[6] += mk * bf_lo(w[k].w); sum[7] += mk * bf_hi(w[k].w); } }
#pragma unroll 1
        for (int g4 = 0; g4 < 4; ++g4) { const int ib = i0 + 4 * g4; u32x4 ws_[4], wa[4], wb[4];
#pragma unroll
            for (int t = 0; t < 4; ++t) { const int i = ib + t; int ra = i + half; ra = ra > SEQ - 1 ? SEQ - 1 : ra; int rb = i - half; rb = rb < 0 ? 0 : rb;
                ws_[t] = *(const u32x4*)(Pb + (size_t)i * FW); wa[t] = *(const u32x4*)(Pb + (size_t)ra * FW); wb[t] = *(const u32x4*)(Pb + (size_t)rb * FW); }
#pragma unroll
            for (int t = 0; t < 4; ++t) { const int i = ib + t;
                int l2 = i - half; if (l2 < 0) l2 = 0; int h2 = i + half; if (h2 > SEQ) h2 = SEQ;
                const float inv = 1.0f / (float)(h2 - l2);
                const float f[8] = {bf_lo(ws_[t].x), bf_hi(ws_[t].x), bf_lo(ws_[t].y), bf_hi(ws_[t].y), bf_lo(ws_[t].z), bf_hi(ws_[t].z), bf_lo(ws_[t].w), bf_hi(ws_[t].w)}; float o[8];
#pragma unroll
                for (int q = 0; q < 8; ++q) o[q] = sum[q] * inv - f[q];
                u32x4 w; w.x = pk2(o[0], o[1]); w.y = pk2(o[2], o[3]); w.z = pk2(o[4], o[5]); w.w = pk2(o[6], o[7]);
                *(u32x4*)(Z + (size_t)(b * SEQ + i) * UVZ + 2 * FW + cb * 8) = w;
                const float ma = (i + half < SEQ) ? 1.f : 0.f, mb = (i - half >= 0) ? 1.f : 0.f;
                sum[0] += ma * bf_lo(wa[t].x) - mb * bf_lo(wb[t].x); sum[1] += ma * bf_hi(wa[t].x) - mb * bf_hi(wb[t].x); sum[2] += ma * bf_lo(wa[t].y) - mb * bf_lo(wb[t].y); sum[3] += ma * bf_hi(wa[t].y) - mb * bf_hi(wb[t].y);
                sum[4] += ma * bf_lo(wa[t].z) - mb * bf_lo(wb[t].z); sum[5] += ma * bf_hi(wa[t].z) - mb * bf_hi(wb[t].z); sum[6] += ma * bf_lo(wa[t].w) - mb * bf_lo(wb[t].w); sum[7] += ma * bf_hi(wa[t].w) - mb * bf_hi(wb[t].w); } }
    }
}

__device__ __forceinline__ float reduce16(const float (&a)[16], int lane) {
    float b8[8], b4[4], b2[2];
    { const bool hi = lane & 32;
#pragma unroll
      for (int i = 0; i < 8; ++i) { const float snd = hi ? a[i] : a[i + 8], kp = hi ? a[i + 8] : a[i]; b8[i] = kp + __shfl_xor(snd, 32); } }
    { const bool hi = lane & 16;
#pragma unroll
      for (int i = 0; i < 4; ++i) { const float snd = hi ? b8[i] : b8[i + 4], kp = hi ? b8[i + 4] : b8[i]; b4[i] = kp + __shfl_xor(snd, 16); } }
    { const bool hi = lane & 8;
#pragma unroll
      for (int i = 0; i < 2; ++i) { const float snd = hi ? b4[i] : b4[i + 2], kp = hi ? b4[i + 2] : b4[i]; b2[i] = kp + __shfl_xor(snd, 8); } }
    const bool hi = lane & 4; const float snd = hi ? b2[0] : b2[1], kp = hi ? b2[1] : b2[0]; float r = kp + __shfl_xor(snd, 4);
    r += __shfl_xor(r, 2); r += __shfl_xor(r, 1);
    return r;
}
__device__ __forceinline__ void p6_rows(const Args& a, LAS unsigned char* lds, int gw, int NGW, int lane, int tid) {
    LAS float* wt = (LAS float*)lds;
    for (int i = tid; i < D * NE / 4; i += NTHR) { const int dd = i & (D - 1), eq = i >> 11; const f32x4 v = *(const f32x4*)(a.in[I_WROUTER] + (size_t)dd * NE + 4 * eq);
#pragma unroll
        for (int q = 0; q < 4; ++q) wt[(4 * eq + q) * D + dd] = v[q]; }
    LDS_WAIT(); __syncthreads();
    const float* gm = a.in[I_NMOE]; unsigned char* V = (unsigned char*)(a.ws + WS_RA); float* AFF = (float*)(a.ws + WS_AFF);
    for (int i = gw * 64 + lane; i < NPAN * CAP * 8; i += NGW * 64) *(i32x4*)(a.ws + WS_RB + (size_t)(i >> 3) * HP + FF + 16 * (i & 7)) = (i32x4){0, 0, 0, 0};
    const int eL = ((lane >> 5) & 1) * 8 + ((lane >> 4) & 1) * 4 + ((lane >> 3) & 1) * 2 + ((lane >> 2) & 1);
#pragma unroll 1
    for (int m0 = gw; m0 < T; m0 += 2 * NGW) {
        f32x4 v[2][8]; u32x2 dl[2][8];
#pragma unroll
        for (int r = 0; r < 2; ++r) { const int m = min(m0 + r * NGW, T - 1); const f32x4* xr = (const f32x4*)(a.in[I_X] + (size_t)m * D) + lane; const u32x2* dr = (const u32x2*)(a.out + (size_t)m * D) + lane;
#pragma unroll
            for (int j = 0; j < 8; ++j) { v[r][j] = __builtin_nontemporal_load(xr + 64 * j); dl[r][j] = dr[64 * j]; } }
#pragma unroll
        for (int r = 0; r < 2; ++r) { float s = 0.f;
#pragma unroll
            for (int j = 0; j < 8; ++j) { const u32x2 w = dl[r][j]; v[r][j][0] += bf_lo(w.x); v[r][j][1] += bf_hi(w.x); v[r][j][2] += bf_lo(w.y); v[r][j][3] += bf_hi(w.y);
                s += (v[r][j][0] * v[r][j][0] + v[r][j][1] * v[r][j][1]) + (v[r][j][2] * v[r][j][2] + v[r][j][3] * v[r][j][3]); }
            { const int mh = m0 + r * NGW;
              if (mh < T) { u32x2* hr = (u32x2*)(a.out + (size_t)mh * D) + lane;
#pragma unroll
                  for (int j = 0; j < 8; ++j) { u32x2 o; o.x = pk2(v[r][j][0], v[r][j][1]); o.y = pk2(v[r][j][2], v[r][j][3]); hr[64 * j] = o; } } }
            const float rstd = 1.0f / sqrtf(wave_sum(s) * (1.0f / D) + EPS);
            const float* gmp = gm; asm volatile("" : "+s"(gmp));
#pragma unroll
            for (int j = 0; j < 8; ++j) { const f32x4 g = ((const f32x4*)gmp)[lane + 64 * j]; v[r][j] = v[r][j] * g * rstd; }
            const int m = m0 + r * NGW;
            if (m < T) { unsigned* o4 = (unsigned*)(V + (size_t)m * D) + lane;
#pragma unroll
                for (int j = 0; j < 8; ++j) { int w = 0; w = __builtin_amdgcn_cvt_pk_fp8_f32(v[r][j][0], v[r][j][1], w, false); w = __builtin_amdgcn_cvt_pk_fp8_f32(v[r][j][2], v[r][j][3], w, true); o4[64 * j] = (unsigned)w; } } }
        float lg0 = 0.f, lg1 = 0.f;
#pragma unroll 1
        for (int e = 0; e < NE; ++e) { float a0 = 0.f, a1 = 0.f; const LAS float* we = wt + e * D + 4 * lane;
#pragma unroll
            for (int j = 0; j < 8; ++j) { const f32x4 w = *(const LAS f32x4*)(we + 256 * j);
                a0 += (v[0][j][0] * w[0] + v[0][j][1] * w[1]) + (v[0][j][2] * w[2] + v[0][j][3] * w[3]); a1 += (v[1][j][0] * w[0] + v[1][j][1] * w[1]) + (v[1][j][2] * w[2] + v[1][j][3] * w[3]); }
            a0 = wave_sum(a0); a1 = wave_sum(a1); if (eL == e) { lg0 = a0; lg1 = a1; } }
#pragma unroll
        for (int r = 0; r < 2; ++r) { const float lg = r ? lg1 : lg0; float mx = lg;
            mx = fmaxf(mx, dpp_mov<0x141>(mx)); mx = fmaxf(mx, dpp_mov<0x140>(mx));
            mx = fmaxf(fmaxf(lane_val(mx, 0), lane_val(mx, 16)), fmaxf(lane_val(mx, 32), lane_val(mx, 48)));
            const float ex = expf(lg - mx); float den = ex;
            den += dpp_mov<0x141>(den); den += dpp_mov<0x140>(den);
            den = (lane_val(den, 0) + lane_val(den, 16)) + (lane_val(den, 32) + lane_val(den, 48));
            const int m = m0 + r * NGW;
            if (m < T && (lane & 3) == 0) AFF[((size_t)(m >> 11) * NE + eL) * SEQ + (m & (SEQ - 1))] = ex / den; }
    }
    __syncthreads();
}

__device__ __forceinline__ void p7_topk(const Args& a, LAS unsigned char* lds, int G, const int tid) {
    LAS unsigned* red = (LAS unsigned*)lds;
    const int lane = tid & 63, wave = tid >> 6;
    const float* AFF = (const float*)(a.ws + WS_AFF); int* IDX = (int*)(a.ws + WS_IDX); float* GATE = (float*)(a.ws + WS_GATE); int* INV = (int*)(a.ws + WS_INV);
    for (int p = blockIdx.x; p < NPAN; p += G) {
        const int b = p >> 4, e = p & 15;
        unsigned v[4];
#pragma unroll
        for (int k = 0; k < 4; ++k) v[k] = __builtin_bit_cast(unsigned, AFF[((size_t)b * NE + e) * SEQ + 4 * tid + k]);
        unsigned prefix = 0u;
        for (int bit = 30; bit >= 0; --bit) {
            const unsigned Tt = prefix | (1u << bit); unsigned c = 0;
#pragma unroll
            for (int k = 0; k < 4; ++k) c += (unsigned)__popcll(__ballot(v[k] >= Tt));
            LAS unsigned* rb = red + (bit & 1) * 8;
            if (lane == 0) rb[wave] = c;
            LDS_WAIT(); __syncthreads();
            unsigned tot = 0;
#pragma unroll
            for (int w = 0; w < 8; ++w) tot += rb[w];
            if (tot >= (unsigned)CAP) prefix = Tt;
        }
        unsigned cg_ = 0, ce_ = 0;
#pragma unroll
        for (int k = 0; k < 4; ++k) { cg_ += v[k] > prefix; ce_ += v[k] == prefix; }
        unsigned sg = cg_, se = ce_;
#pragma unroll
        for (int o = 1; o < 64; o <<= 1) { const unsigned tg = __shfl_up(sg, o), te = __shfl_up(se, o); if (lane >= o) { sg += tg; se += te; } }
        LAS unsigned* sc = red + 64;
        __syncthreads();
        if (lane == 63) { sc[wave] = sg; sc[8 + wave] = se; }
        LDS_WAIT(); __syncthreads();
        unsigned bg = 0, be = 0, totg = 0;
#pragma unroll
        for (int w = 0; w < 8; ++w) { const unsigned xg = sc[w], xe = sc[8 + w]; if (w < wave) { bg += xg; be += xe; } totg += xg; }
        unsigned eg = bg + sg - cg_, ee = be + se - ce_;
        const unsigned need = (unsigned)CAP - totg;
#pragma unroll
        for (int k = 0; k < 4; ++k) { const int n = 4 * tid + k; int slot = -1;
            if (v[k] > prefix) { slot = (int)eg; ++eg; }
            else if (v[k] == prefix) { if (ee < need) slot = (int)(totg + ee); ++ee; }
            if (slot >= 0) { IDX[p * CAP + slot] = n; GATE[p * CAP + slot] = __builtin_bit_cast(float, v[k]); }
            INV[(size_t)(b * SEQ + n) * NE + e] = slot; }
        __syncthreads();
    }
}

__device__ __forceinline__ void p8_gather(const Args& a, int gw, int NGW, int lane) {
    const bf16_t* V = (const bf16_t*)(a.ws + WS_RA); bf16_t* Xs = (bf16_t*)(a.ws + WS_RD); const int* IDX = (const int*)(a.ws + WS_IDX);
    for (int r = gw; r < NPAN * CAP; r += NGW) { const int p = r >> 8, b = p >> 4; const int n = IDX[r];
        const u32x4* src = (const u32x4*)(V + (size_t)(b * SEQ + n) * D) + lane; u32x4* dst = (u32x4*)(Xs + (size_t)r * D) + lane;
        u32x4 t[4];
#pragma unroll
        for (int j = 0; j < 4; ++j) t[j] = src[64 * j];
#pragma unroll
        for (int j = 0; j < 4; ++j) dst[64 * j] = t[j]; }
}

__device__ __forceinline__ void p11_final(const Args& a, int gw, int NGW, int lane, float* dst) {
    float* out = a.out; const unsigned char* Y = (const unsigned char*)(a.ws + WS_RD); const int* INV = (const int*)(a.ws + WS_INV); const float* gf = a.in[I_NFINAL];
    for (int m = gw; m < T; m += NGW) { f32x4* xr = (f32x4*)(dst + (size_t)m * D) + lane; const u32x2* dr = (const u32x2*)(out + (size_t)m * D) + lane; f32x4 v[8];
#pragma unroll
        for (int j = 0; j < 8; ++j) { const u32x2 w = dr[64 * j]; v[j][0] = bf_lo(w.x); v[j][1] = bf_hi(w.x); v[j][2] = bf_lo(w.y); v[j][3] = bf_hi(w.y); }
        const int b = m >> 11;
        i32x4 iv[4];
#pragma unroll
        for (int q = 0; q < 4; ++q) iv[q] = *(const i32x4*)(INV + (size_t)m * NE + 4 * q);
#pragma unroll
        for (int e = 0; e < NE; ++e) { const int slot = __builtin_amdgcn_readfirstlane(iv[e >> 2][e & 3]);
            if (slot >= 0) { const unsigned* yr = (const unsigned*)(Y + ((size_t)(b * NE + e) * CAP + slot) * D) + lane;
#pragma unroll
                for (int j = 0; j < 8; ++j) { const unsigned w = yr[64 * j]; const f32x2 lo = __builtin_amdgcn_cvt_pk_f32_fp8((int)w, false), hi = __builtin_amdgcn_cvt_pk_f32_fp8((int)w, true);
                    v[j][0] += lo[0] * (1.0f / YSC); v[j][1] += lo[1] * (1.0f / YSC); v[j][2] += hi[0] * (1.0f / YSC); v[j][3] += hi[1] * (1.0f / YSC); } } }
        float s = 0.f;
#pragma unroll
        for (int j = 0; j < 8; ++j) s += (v[j][0] * v[j][0] + v[j][1] * v[j][1]) + (v[j][2] * v[j][2] + v[j][3] * v[j][3]);
        const float rstd = 1.0f / sqrtf(wave_sum(s) * (1.0f / D) + EPS);
#pragma unroll
        for (int j = 0; j < 8; ++j) { const f32x4 g = ((const f32x4*)gf)[lane + 64 * j]; __builtin_nontemporal_store(v[j] * g * rstd, xr + 64 * j); } }
}

#define XB_TMO      128
#define XB_XCNT(j)  (256  + 64 * (j))
#define XB_XSUB(j)  (1280 + 64 * (j))
#define XB_XGEN(j)  (2304 + 64 * (j))
#define XB_TOP      3328
#define XB_TOPGEN   3392
#define XCD_BAR_WORDS 3456
#define XB_SPIN_CAP (1u << 22)
__device__ __forceinline__ unsigned xb_ld(unsigned* p)              { return __hip_atomic_load(p, __ATOMIC_RELAXED, __HIP_MEMORY_SCOPE_AGENT); }
__device__ __forceinline__ unsigned xb_add(unsigned* p, unsigned v) { return __hip_atomic_fetch_add(p, v, __ATOMIC_RELAXED, __HIP_MEMORY_SCOPE_AGENT); }
__device__ __forceinline__ unsigned xb_xcc_id() { return (unsigned)__builtin_amdgcn_s_getreg((3 << 11) | 20) & 0xFu; }
#define XB_SPIN(cond, bar) do { unsigned _sp = 0; while (cond) { __builtin_amdgcn_s_sleep(1); \
    if ((++_sp & 255u) == 0u) { if (xb_ld(&(bar)[XB_TMO])) break; if (_sp > XB_SPIN_CAP) { atomicAdd(&(bar)[XB_TMO], 1u); break; } } } } while (0)
struct XcdBarrier { unsigned* bar; unsigned x; volatile LAS unsigned* st; };
__device__ __forceinline__ XcdBarrier xcd_barrier_post(unsigned* bar, volatile LAS unsigned* st) {
    XcdBarrier b; b.bar = bar; b.x = xb_xcc_id(); b.st = st;
    if (threadIdx.x == 0) (void)xb_add(&bar[XB_XCNT(b.x)], 1u);
    return b;
}
__device__ __forceinline__ void xcd_barrier_complete(unsigned* bar, unsigned x, unsigned& nloc, unsigned& nx) {
    const unsigned G = gridDim.x * gridDim.y * gridDim.z;
    unsigned sum, cnt, mine, sp = 0u;
    for (;;) {
        sum = 0u; cnt = 0u; mine = 0u;
#pragma unroll
        for (unsigned j = 0; j < 16; ++j) { const unsigned c = xb_ld(&bar[XB_XCNT(j)]); sum += c; cnt += (c > 0u) ? 1u : 0u; mine = (j == x) ? c : mine; }
        if (sum == G) break;
        __builtin_amdgcn_s_sleep(1);
        if ((++sp & 255u) == 0u) { if (xb_ld(&bar[XB_TMO])) break; if (sp > XB_SPIN_CAP) { atomicAdd(&bar[XB_TMO], 1u); break; } }
    }
    nloc = mine > 0u ? mine : 1u; nx = cnt > 0u ? cnt : 1u;
}
__device__ __forceinline__ void xcd_barrier(const XcdBarrier& b) {
    asm volatile("s_waitcnt vmcnt(0)" ::: "memory");
    __syncthreads();
    if (threadIdx.x == 0) {
        unsigned* bar = b.bar;
        __builtin_amdgcn_s_waitcnt(0);
        unsigned nloc = b.st[0], nx = b.st[1];
        if (nloc == 0u) { xcd_barrier_complete(bar, b.x, nloc, nx); b.st[0] = nloc; b.st[1] = nx; }
        const unsigned old = xb_add(&bar[XB_XSUB(b.x)], 1u);
        const unsigned gen = old / nloc;
        if (old + 1u == (gen + 1u) * nloc) {
            __builtin_amdgcn_fence(__ATOMIC_RELEASE, "agent");
            asm volatile("s_waitcnt vmcnt(0)" ::: "memory");
            const unsigned og = xb_add(&bar[XB_TOP], 1u);
            const unsigned tg = og / nx;
            if (og + 1u == (tg + 1u) * nx) xb_add(&bar[XB_TOPGEN], 1u);
            else XB_SPIN(xb_ld(&bar[XB_TOPGEN]) == tg, bar);
            __builtin_amdgcn_fence(__ATOMIC_ACQUIRE, "agent");
            xb_add(&bar[XB_XGEN(b.x)], 1u);
            asm volatile("s_waitcnt vmcnt(0)" ::: "memory");
        } else {
            XB_SPIN(xb_ld(&bar[XB_XGEN(b.x)]) == gen, bar);
            __builtin_amdgcn_fence(__ATOMIC_ACQUIRE, "agent");
            asm volatile("s_waitcnt vmcnt(0)" ::: "memory");
        }
    }
    __syncthreads();
}

__global__ void __launch_bounds__(NTHR, 2) fwd_kernel(Args args) {
    extern __shared__ __attribute__((aligned(16))) unsigned char lds_raw[];
    LAS unsigned char* lds = (LAS unsigned char*)lds_raw;
    volatile LAS unsigned* misc = (volatile LAS unsigned*)(lds + MISC_OFF);
    if (threadIdx.x < 64) misc[threadIdx.x] = 0u;
    __syncthreads();
    XcdBarrier xbar = xcd_barrier_post((unsigned*)args.ws, misc);
    const int G = gridDim.x, bx = blockIdx.x;
    const int vcu = (G % 8 == 0) ? (bx % 8) * (G / 8) + bx / 8 : bx;
    constexpr unsigned SEAMS = (1u << 0) | (1u << 7) | (1u << 8) | (1u << 10) | (1u << 11) | (1u << 12) | (1u << 13) | (1u << 14) | (1u << 15) | (1u << 16);
    const int slot = (bx % 8) >> 1;
    if (PROBE_SEL >= 0 && bx == 0 && threadIdx.x == 0) misc[7] = (unsigned)__builtin_amdgcn_s_memrealtime();
    for (int pos = args.ph_lo, rep = 0; pos < args.ph_hi; ) {
        int tid = threadIdx.x; asm volatile("" : "+v"(tid));
        int Gs = G; asm volatile("" : "+s"(Gs));
        const int lane = tid & 63, wave = __builtin_amdgcn_readfirstlane(tid >> 6);
        const int gw = vcu * NWAVES + wave, NGW = Gs * NWAVES;
        int step = pos;
        if (pos >= 4 && pos <= 7) { const int q = pos - 4; step = (q == slot) ? 100 : 4 + (q < slot ? q : q - 1); } else if (pos > 7) step = pos - 1;
        int gid = -1;
        switch (step) {
        case 0: p0_prologue(args, lds, gw, NGW, wave, lane); break;
        case 100: p0_items(args, lds, gw, NGW, wave, lane, P0_NBASE, P0_NITEMS); LDS_WAIT(); __syncthreads(); break;
        case 1: gid = G_MGU; break; case 2: gid = G_MGV; break; case 3: gid = G_MGP; break;
        case 4: gid = G_1A; break; case 5: gid = G_1B; break; case 6: gid = G_1C; break;
        case 7: p3_fold(args, gw, NGW, lane); p3_pool(args, gw * 64 + lane, NGW * 64); break;
        case 8: gid = G_DFTU; break; case 9: gid = G_DFTV; break;
        case 10: gid = G_4; break;
        case 11: gid = G_OUT; break;
        case 12: p6_rows(args, lds, gw, NGW, lane, tid); break;
        case 13: p7_topk(args, lds, Gs, tid); break;
        case 14: gid = G_GU; break;
        case 15: gid = G_DOWN; break;
        default: p11_final(args, gw, NGW, lane, args.out); break;
        }
        if (gid >= 0) { GemmDesc d_; make_desc(gid, args, d_); if (gid == G_GU) gemm_run<true, false, true>(lds, d_, Gs, bx, tid); else if (gid == G_DOWN || gid == G_1C) gemm_run<false, false, true>(lds, d_, Gs, bx, tid); else gemm_run<false, true, false>(lds, d_, Gs, bx, tid); }
        if (((PROBE_MASK >> pos) & 1u) && rep == 0) { rep = 1; xcd_barrier(xbar); continue; }
        rep = 0;
        if (((SEAMS >> pos) & 1u) && pos + 1 < args.ph_hi) xcd_barrier(xbar);
        ++pos;
        if (PROBE_SEL >= 0 && bx == 0 && tid == 0) misc[8 + pos] = (unsigned)__builtin_amdgcn_s_memrealtime();
    }
    if (PROBE_SEL >= 0 && bx == 0) { __syncthreads(); if (threadIdx.x == 0) { const unsigned t0 = (PROBE_SEL == 0) ? misc[7] : misc[8 + PROBE_SEL], t1 = misc[8 + PROBE_SEL_END];
        asm volatile("s_waitcnt vmcnt(0)" ::: "memory"); args.out[0] += (float)(t1 - t0) * 0.001f; } }
}

extern "C" void kernel_launch(void* const* d_in, const int* in_sizes, int n_in, void* d_out, int out_size, void* d_ws, size_t ws_size, hipStream_t stream) {
    static int grid = 0;
    if (grid == 0) {
        if (n_in != 17 || in_sizes[0] != T * D || out_size != T * D || ws_size < WS_END) { fprintf(stderr, "kernel_launch: unexpected shapes (n_in %d, in0 %d, out %d, ws %zu < %zu); nothing launched\n", n_in, n_in > 0 ? in_sizes[0] : -1, out_size, ws_size, (size_t)WS_END); grid = -1; return; }
        int dev = 0, cus = 0, per_cu = 0;
        if (hipGetDevice(&dev) != hipSuccess || hipDeviceGetAttribute(&cus, hipDeviceAttributeMultiprocessorCount, dev) != hipSuccess) { grid = -1; return; }
        if (hipFuncSetAttribute((const void*)fwd_kernel, hipFuncAttributeMaxDynamicSharedMemorySize, LDS_BYTES) != hipSuccess) { fprintf(stderr, "kernel_launch: hipFuncSetAttribute failed\n"); grid = -1; return; }
        if (hipOccupancyMaxActiveBlocksPerMultiprocessor(&per_cu, (const void*)fwd_kernel, NTHR, LDS_BYTES) != hipSuccess || per_cu < 1) { fprintf(stderr, "kernel_launch: occupancy query failed (%d)\n", per_cu); (void)hipGetLastError(); grid = -1; return; }
        grid = cus * per_cu;
        fprintf(stderr, "kernel_launch: %d CUs x %d per CU = grid %d\n", cus, per_cu, grid);
    }
    if (grid < 0) return;
    if (hipMemsetAsync(d_ws, 0, CTL_ZERO_BYTES, stream) != hipSuccess) { fprintf(stderr, "kernel_launch: hipMemsetAsync failed\n"); return; }
    Args a; memset(&a, 0, sizeof(a));
    for (int i = 0; i < 17; ++i) a.in[i] = (const float*)d_in[i];
    a.out = (float*)d_out; a.ws = (unsigned char*)d_ws;
    if (MK_N_LAUNCHES == 1) {
        a.ph_lo = 0; a.ph_hi = N_STEPS; void* kargs[] = {&a};
        hipError_t e = hipLaunchCooperativeKernel((const void*)fwd_kernel, dim3(grid), dim3(NTHR), kargs, LDS_BYTES, stream);
        if (e != hipSuccess) fprintf(stderr, "kernel_launch: cooperative launch failed: %s (grid %d)\n", hipGetErrorString(e), grid);
    } else {
        static const int cuts[12] = {0, 1, 8, 9, 11, 12, 13, 14, 15, 16, 17, 18};
        for (int p = 0; p < 11; ++p) { a.ph_lo = cuts[p]; a.ph_hi = cuts[p + 1]; void* kargs[] = {&a};
            hipError_t e = hipLaunchCooperativeKernel((const void*)fwd_kernel, dim3(grid), dim3(NTHR), kargs, LDS_BYTES, stream);
            if (e != hipSuccess) { fprintf(stderr, "kernel_launch: launch %d failed: %s (grid %d)\n", p, hipGetErrorString(e), grid); break; } }
    }
}
```

```cpp
#include <hip/hip_runtime.h>
#include <hip/hip_cooperative_groups.h>
#include <cstdio>
#include <cstdint>
#include <cstring>
namespace cg = cooperative_groups;

#define PROBE_MASK 0u
#define PROBE_SEL (-1)
#define PROBE_SEL_END (PROBE_SEL + 1)
#ifndef MK_N_LAUNCHES
#define MK_N_LAUNCHES 1
#endif

#define LAS __attribute__((address_space(3)))
typedef unsigned short bf16_t;
typedef short bf16x8 __attribute__((ext_vector_type(8)));
typedef float f32x4 __attribute__((ext_vector_type(4)));
typedef float f32x2 __attribute__((ext_vector_type(2)));
typedef unsigned u32x4 __attribute__((ext_vector_type(4)));
typedef unsigned u32x2 __attribute__((ext_vector_type(2)));
typedef int i32x4 __attribute__((ext_vector_type(4)));
typedef int i32x8 __attribute__((ext_vector_type(8)));

constexpr int BATCH = 8, SEQ = 2048, D = 2048, T = BATCH * SEQ;
constexpr int NE = 16, FF = 1408, CAP = 256, NPAN = BATCH * NE;
constexpr int FW = 1024;
constexpr int HP = 1536;
constexpr float EPS = 1e-6f;
constexpr float YSC = 16.0f;
constexpr int NWAVES = 8, NTHR = 512;
constexpr int N_STEPS = 18;

constexpr size_t MiB = 1u << 20;
constexpr size_t WS_WTIN = 2 * MiB;
constexpr size_t WS_WTG = 10 * MiB;
constexpr size_t WS_WBFT = 26 * MiB;
constexpr size_t WS_WBPT = 30 * MiB;
constexpr size_t WS_WUVP = 596 * MiB;
constexpr size_t WS_WOUT = 46 * MiB;
constexpr size_t WS_MIXC = 54 * MiB;
constexpr size_t WS_MIXS = 54 * MiB + 512 * 1024;
constexpr size_t WS_MIXP = 55 * MiB;
constexpr size_t WS_TC = 56 * MiB;
constexpr size_t WS_TS = 59 * MiB;
constexpr size_t WS_WGU = 64 * MiB;
constexpr size_t WS_WD = 152 * MiB;
constexpr size_t WS_RA = 200 * MiB;
constexpr size_t WS_RB = 264 * MiB;
constexpr size_t WS_RC = 296 * MiB;
constexpr size_t WS_PP = 328 * MiB;
constexpr size_t WS_PM = 346 * MiB;
constexpr size_t WS_RD = 364 * MiB;
constexpr size_t WS_RE = 492 * MiB;
constexpr size_t WS_AFF = 592 * MiB;
constexpr size_t WS_INV = 593 * MiB;
constexpr size_t WS_IDX = 594 * MiB;
constexpr size_t WS_GATE = 594 * MiB + 256 * 1024;
constexpr size_t WS_END = 609 * MiB;
constexpr int KU = 1152, UVZ = 3 * FW + 64, KUVZ = 3 * FW;

constexpr int LDS_BYTES = 155648;
constexpr int MISC_OFF = LDS_BYTES - 256;
constexpr size_t CTL_ZERO_BYTES = 65536;

__device__ __forceinline__ unsigned f2bf(float f) { unsigned u = __builtin_bit_cast(unsigned, f); return (u + 0x7fffu + ((u >> 16) & 1u)) >> 16; }
__device__ __forceinline__ unsigned pk2(float lo, float hi) { return f2bf(lo) | (f2bf(hi) << 16); }
__device__ __forceinline__ unsigned cvt_pk_bf16(float lo, float hi) { unsigned r; asm volatile("v_cvt_pk_bf16_f32 %0, %1, %2" : "=v"(r) : "v"(lo), "v"(hi)); return r; }
__device__ __forceinline__ float bf_lo(unsigned w) { return __builtin_bit_cast(float, w << 16); }
__device__ __forceinline__ float bf_hi(unsigned w) { return __builtin_bit_cast(float, w & 0xffff0000u); }
template <int CTRL> __device__ __forceinline__ float dpp_mov(float v) { return __builtin_bit_cast(float, __builtin_amdgcn_update_dpp(0, __builtin_bit_cast(int, v), CTRL, 0xf, 0xf, false)); }
__device__ __forceinline__ float lane_val(float v, int l) { return __builtin_bit_cast(float, __builtin_amdgcn_readlane(__builtin_bit_cast(int, v), l)); }
__device__ __forceinline__ float wave_sum(float v) {
    v += dpp_mov<0xB1>(v); v += dpp_mov<0x4E>(v); v += dpp_mov<0x141>(v); v += dpp_mov<0x140>(v);
    return (lane_val(v, 0) + lane_val(v, 16)) + (lane_val(v, 32) + lane_val(v, 48));
}
__device__ __forceinline__ float sigmoidf_fast(float x) { return __builtin_amdgcn_rcpf(1.0f + __builtin_amdgcn_exp2f(-1.4426950408889634f * x)); }
#define LDS_WAIT() asm volatile("s_waitcnt lgkmcnt(0)" ::: "memory")
#define VM_WAIT() asm volatile("s_waitcnt vmcnt(0)" ::: "memory")

constexpr int BM = 256, BK = 64, HALF = 128, HTB = HALF * BK * 2, NXCD = 8, WGM = 4;
__device__ __forceinline__ int lds_byte(int r, int c) { const int st = (r >> 4) * 2 + (c >> 5), rr = r & 15, cc = c & 31, ob = rr * 64 + cc * 2; return st * 1024 + (ob ^ (((ob >> 9) & 1) << 5)); }
__device__ __forceinline__ void stage_rc(int b, int& R, int& C) { const int st = b / 1024, sb = b % 1024, swz = sb ^ (((sb >> 9) & 1) << 5); R = (st >> 1) * 16 + swz / 64; C = (st & 1) * 32 + (swz % 64) / 2; }
__device__ __forceinline__ int perm32(int rho) { const int n = rho >> 4, i = rho & 15; return 8 * (i >> 2) + 4 * n + (i & 3); }

enum EpiMode { EPI_STORE = 0, EPI_PG = 1, EPI_GATED = 2, EPI_MIRROR = 3, EPI_SWIGLU = 5, EPI_ROWSCALE = 6 };
struct GemmDesc {
    const char* A; const char* B;
    int lda, ldb, K;
    int nM, nN, nZ;
    long sAz, sAm, sBz, sBn;
    int rz, rm;
    int mode, perm;
    int coff;
    int hook_t;
    const void* gidx;
    void* O; int ldc; long oz;
    const void* P1; const void* P2;
};
struct Unit { unsigned A, B; int row0, col0, z; };

__device__ __forceinline__ bool unit_next(const GemmDesc& d, int i, int G, int c, Unit& u) {
    if (c < 0) return false;
    const int nwg = d.nM * d.nN; const long L = (long)i * G + c;
    if (L >= (long)nwg * d.nZ) return false;
    const int z = (int)(L / nwg); int wgid = (int)(L % nwg);
    { const int q = nwg / NXCD, r = nwg % NXCD, xcd = wgid % NXCD, off = wgid / NXCD; wgid = (xcd < r ? xcd * (q + 1) : r * (q + 1) + (xcd - r) * q) + off; }
    const int nig = WGM * d.nN, gid = wgid / nig, fm = gid * WGM, gsz = (d.nM - fm) < WGM ? (d.nM - fm) : WGM;
    const int pm = fm + ((wgid % nig) % gsz), pn = (wgid % nig) / gsz;
    u.A = (unsigned)((long)z * d.sAz + (long)pm * d.sAm); u.B = (unsigned)((long)z * d.sBz + (long)pn * d.sBn);
    u.row0 = z * d.rz + pm * d.rm; u.col0 = pn * BM; u.z = z; return true;
}

__device__ __forceinline__ void epilogue(const GemmDesc& d, const f32x4 (&acc)[2][2][4][2], const Unit& u, int wr, int wc, int fr, int fq) {
    const int rowb = u.row0 + wr * 64 + fr;
    if (d.mode == EPI_STORE) {
        bf16_t* O = (bf16_t*)d.O + (size_t)u.z * d.oz; const int col0 = u.col0 + wc * 32 + 8 * fq;
#pragma unroll
        for (int ai = 0; ai < 2; ++ai)
#pragma unroll
            for (int m = 0; m < 4; ++m) { bf16_t* rowp = O + (size_t)(rowb + ai * HALF + m * 16) * d.ldc + col0;
#pragma unroll
                for (int bj = 0; bj < 2; ++bj) { const f32x4 v0 = acc[ai][bj][m][0], v1 = acc[ai][bj][m][1];
                    u32x4 w; w.x = cvt_pk_bf16(v0[0], v0[1]); w.y = cvt_pk_bf16(v0[2], v0[3]); w.z = cvt_pk_bf16(v1[0], v1[1]); w.w = cvt_pk_bf16(v1[2], v1[3]);
                    *(u32x4*)(rowp + bj * HALF) = w; } }
    } else if (d.mode == EPI_MIRROR) {
        bf16_t* O = (bf16_t*)d.O; const int col0 = u.col0 + wc * 32 + 8 * fq; const float sgn = d.oz ? -1.0f : 1.0f;
        const int kb = (u.row0 & (SEQ - 1)) + wr * 64 + fr, zb = u.row0 & ~(SEQ - 1);
#pragma unroll
        for (int ai = 0; ai < 2; ++ai)
#pragma unroll
            for (int m = 0; m < 4; ++m) { const int k = kb + ai * HALF + m * 16; bf16_t* rowp = O + (size_t)(zb + k) * UVZ + col0; bf16_t* rowm = O + (size_t)(zb + SEQ - k) * UVZ + col0;
#pragma unroll
                for (int bj = 0; bj < 2; ++bj) { const f32x4 v0 = acc[ai][bj][m][0], v1 = acc[ai][bj][m][1];
                    u32x4 w; w.x = cvt_pk_bf16(v0[0], v0[1]); w.y = cvt_pk_bf16(v0[2], v0[3]); w.z = cvt_pk_bf16(v1[0], v1[1]); w.w = cvt_pk_bf16(v1[2], v1[3]);
                    *(u32x4*)(rowp + bj * HALF) = w;
                    if (k > 0) { u32x4 x; x.x = cvt_pk_bf16(sgn * v0[0], sgn * v0[1]); x.y = cvt_pk_bf16(sgn * v0[2], sgn * v0[3]); x.z = cvt_pk_bf16(sgn * v1[0], sgn * v1[1]); x.w = cvt_pk_bf16(sgn * v1[2], sgn * v1[3]);
                        *(u32x4*)(rowm + bj * HALF) = x; } } }
    } else if (d.mode == EPI_PG) {
        if (d.perm) {
            bf16_t* O = (bf16_t*)d.O; const int col0 = u.col0 + wc * 32 + 8 * fq;
#pragma unroll
            for (int ai = 0; ai < 2; ++ai)
#pragma unroll
                for (int m = 0; m < 4; ++m) { bf16_t* rowp = O + (size_t)(rowb + ai * HALF + m * 16) * FW + col0;
#pragma unroll
                    for (int bj = 0; bj < 2; ++bj) { const f32x4 v0 = acc[ai][bj][m][0], v1 = acc[ai][bj][m][1];
                        u32x4 w; w.x = cvt_pk_bf16(v0[0], v0[1]); w.y = cvt_pk_bf16(v0[2], v0[3]); w.z = cvt_pk_bf16(v1[0], v1[1]); w.w = cvt_pk_bf16(v1[2], v1[3]);
                        *(u32x4*)(rowp + bj * HALF) = w; } }
        } else {
            bf16_t* Rr = (bf16_t*)d.P1; bf16_t* Gp = Rr + (size_t)T * D; const float* bias = (const float*)d.P2;
            const int dc0 = (u.col0 >> 1) + wc * 32 + 8 * fq;
            f32x4 bf[2], bp[2];
#pragma unroll
            for (int bj = 0; bj < 2; ++bj) { bf[bj] = *(const f32x4*)(bias + dc0 + 4 * bj); bp[bj] = *(const f32x4*)(bias + D + dc0 + 4 * bj); }
#pragma unroll
            for (int ai = 0; ai < 2; ++ai)
#pragma unroll
                for (int m = 0; m < 4; ++m) { const size_t off = (size_t)(rowb + ai * HALF + m * 16) * D + dc0; float rr[8], gg[8];
#pragma unroll
                    for (int bj = 0; bj < 2; ++bj) { const f32x4 av = acc[ai][bj][m][0] + bf[bj], bv = acc[ai][bj][m][1] + bp[bj];
#pragma unroll
                        for (int j = 0; j < 4; ++j) { const float ea = __builtin_amdgcn_exp2f(-1.4426950408889634f * fmaxf(av[j], -30.f)), eb = __builtin_amdgcn_exp2f(-1.4426950408889634f * fmaxf(bv[j], -30.f));
                            gg[4 * bj + j] = __builtin_amdgcn_rcpf(1.0f + eb); rr[4 * bj + j] = (1.0f + eb) * __builtin_amdgcn_rcpf(1.0f + ea); } }
                    u32x4 w; w.x = cvt_pk_bf16(rr[0], rr[1]); w.y = cvt_pk_bf16(rr[2], rr[3]); w.z = cvt_pk_bf16(rr[4], rr[5]); w.w = cvt_pk_bf16(rr[6], rr[7]);
                    *(u32x4*)(Rr + off) = w;
                    u32x4 g; g.x = cvt_pk_bf16(gg[0], gg[1]); g.y = cvt_pk_bf16(gg[2], gg[3]); g.z = cvt_pk_bf16(gg[4], gg[5]); g.w = cvt_pk_bf16(gg[6], gg[7]);
                    *(u32x4*)(Gp + off) = g; }
        }
    } else if (d.mode == EPI_GATED) {
        bf16_t* O = (bf16_t*)d.O; const bf16_t* Gm = (const bf16_t*)d.P1; const int col0 = u.col0 + wc * 32 + 8 * fq;
#pragma unroll
        for (int ai = 0; ai < 2; ++ai) { u32x4 g[4][2];
#pragma unroll
            for (int m = 0; m < 4; ++m)
#pragma unroll
                for (int bj = 0; bj < 2; ++bj) g[m][bj] = *(const u32x4*)(Gm + (size_t)(rowb + ai * HALF + m * 16) * D + col0 + bj * HALF);
#pragma unroll
            for (int m = 0; m < 4; ++m) { const size_t r = (size_t)(rowb + ai * HALF + m * 16);
#pragma unroll
                for (int bj = 0; bj < 2; ++bj) { const f32x4 v0 = acc[ai][bj][m][0], v1 = acc[ai][bj][m][1]; const u32x4 q = g[m][bj];
                    u32x4 w; w.x = cvt_pk_bf16(v0[0] * bf_lo(q.x), v0[1] * bf_hi(q.x)); w.y = cvt_pk_bf16(v0[2] * bf_lo(q.y), v0[3] * bf_hi(q.y));
                    w.z = cvt_pk_bf16(v1[0] * bf_lo(q.z), v1[1] * bf_hi(q.z)); w.w = cvt_pk_bf16(v1[2] * bf_lo(q.w), v1[3] * bf_hi(q.w));
                    *(u32x4*)(O + r * D + col0 + bj * HALF) = w; } }
            asm volatile("" ::: "memory"); }
    } else if (d.mode == EPI_SWIGLU) {
        unsigned char* O = (unsigned char*)d.O; const int hc0 = (u.col0 >> 1) + wc * 16 + 4 * fq;
#pragma unroll
        for (int ai = 0; ai < 2; ++ai)
#pragma unroll
            for (int m = 0; m < 4; ++m) { unsigned char* rowp = O + (size_t)(rowb + ai * HALF + m * 16) * HP + hc0;
#pragma unroll
                for (int bj = 0; bj < 2; ++bj) { const f32x4 g = acc[ai][bj][m][0], up = acc[ai][bj][m][1]; float h[4];
#pragma unroll
                    for (int j = 0; j < 4; ++j) h[j] = g[j] * sigmoidf_fast(g[j]) * up[j];
                    int w = 0; w = __builtin_amdgcn_cvt_pk_fp8_f32(h[0], h[1], w, false); w = __builtin_amdgcn_cvt_pk_fp8_f32(h[2], h[3], w, true);
                    *(int*)(rowp + bj * 64) = w; } }
    } else {
        unsigned char* O = (unsigned char*)d.O; const float* gs = (const float*)d.P1; const int col0 = u.col0 + wc * 32 + 8 * fq;
        float scv[2][4];
#pragma unroll
        for (int ai = 0; ai < 2; ++ai)
#pragma unroll
            for (int m = 0; m < 4; ++m) scv[ai][m] = gs[(size_t)(rowb + ai * HALF + m * 16)];
#pragma unroll
        for (int ai = 0; ai < 2; ++ai)
#pragma unroll
            for (int m = 0; m < 4; ++m) { const size_t r = (size_t)(rowb + ai * HALF + m * 16); const float sc = scv[ai][m] * YSC; unsigned char* rowp = O + r * D + col0;
#pragma unroll
                for (int bj = 0; bj < 2; ++bj) { const f32x4 v0 = acc[ai][bj][m][0] * sc, v1 = acc[ai][bj][m][1] * sc; int w0 = 0, w1 = 0;
                    w0 = __builtin_amdgcn_cvt_pk_fp8_f32(v0[0], v0[1], w0, false); w0 = __builtin_amdgcn_cvt_pk_fp8_f32(v0[2], v0[3], w0, true);
                    w1 = __builtin_amdgcn_cvt_pk_fp8_f32(v1[0], v1[1], w1, false); w1 = __builtin_amdgcn_cvt_pk_fp8_f32(v1[2], v1[3], w1, true);
                    u32x2 w; w.x = (unsigned)w0; w.y = (unsigned)w1; *(u32x2*)(rowp + bj * HALF) = w; } }
    }
}

__device__ __forceinline__ void midk_scale(const GemmDesc& d, f32x4 (&acc)[2][2][4][2], const Unit& u, int wr, int wc, int fr, int fq) {
    typedef __attribute__((address_space(1))) const bf16_t* gptr;
    gptr p0 = (gptr)((const bf16_t*)d.P2 + (size_t)(u.row0 + wr * 64 + fr) * D + (u.col0 + wc * 32 + 8 * fq));
    asm volatile("" : "+v"(p0));
#pragma unroll
    for (int ai = 0; ai < 2; ++ai) { u32x4 g[4][2];
#pragma unroll
        for (int m = 0; m < 4; ++m)
#pragma unroll
            for (int bj = 0; bj < 2; ++bj) g[m][bj] = *(const __attribute__((address_space(1))) u32x4*)(p0 + (size_t)(ai * HALF + m * 16) * D + bj * HALF);
#pragma unroll
        for (int m = 0; m < 4; ++m)
#pragma unroll
            for (int bj = 0; bj < 2; ++bj) { const u32x4 q = g[m][bj]; f32x4& v0 = acc[ai][bj][m][0]; f32x4& v1 = acc[ai][bj][m][1];
                v0[0] *= bf_lo(q.x); v0[1] *= bf_hi(q.x); v0[2] *= bf_lo(q.y); v0[3] *= bf_hi(q.y); v1[0] *= bf_lo(q.z); v1[1] *= bf_hi(q.z); v1[2] *= bf_lo(q.w); v1[3] *= bf_hi(q.w); }
        asm volatile("" ::: "memory"); }
}

__device__ __forceinline__ void tile_prefetch(const void* base, int row0, int col0, LAS unsigned char* lds, int tid, int wid) {
    const char* p = (const char*)base + ((size_t)(row0 + (tid >> 1)) * D + col0) * 2 + (tid & 1) * 256;
    asm volatile("" : "+v"(p));
    LAS unsigned* dst = (LAS unsigned*)(lds + 131072 + wid * 512);
    __builtin_amdgcn_global_load_lds((const unsigned*)p, dst, 4, 0, 0);
    __builtin_amdgcn_global_load_lds((const unsigned*)(p + 128), dst + 64, 4, 0, 0);
}

template <bool GATHER, bool HOOK, bool FP8>
__device__ __forceinline__ void gemm_run(LAS unsigned char* lds, const GemmDesc& d, int G, int cblk, const int tid) {
    const int wid = __builtin_amdgcn_readfirstlane(tid >> 6), lane = tid & 63, wr = wid >> 2, wc = wid & 3, fr = lane & 15, fq = lane >> 4;
    const int nt = d.K / BK; const int c = cblk - d.coff;
    unsigned voffA[2], voffB[2];
#pragma unroll
    for (int i = 0; i < 2; ++i) { int R, C; stage_rc(tid * 16 + i * 8192, R, C); const int Rb = d.perm ? ((R & ~31) + perm32(R & 31)) : R;
        voffA[i] = (unsigned)(R * d.lda + C) * 2u; voffB[i] = (unsigned)(Rb * d.ldb + C) * 2u; }
    const unsigned kstep = BK * 2;
    const unsigned hstepA = (unsigned)HALF * d.lda * 2, hstepB = (unsigned)HALF * d.ldb * 2;
    const unsigned ldsw = (unsigned)wid * 1024u;
    const int aoff = lds_byte(wr * 64 + fr, fq * 8), boff = lds_byte(wc * 32 + fr, fq * 8);
#define PG8_SA(b, h) (((b) * 2 + (h)) * HTB)
#define PG8_SB(b, h) ((4 + (b) * 2 + (h)) * HTB)
#define PG8_LDA(dst, b, h) do { _Pragma("unroll") for (int m = 0; m < 4; ++m) _Pragma("unroll") for (int k = 0; k < 2; ++k) dst[m][k] = *(const LAS bf16x8*)(lds + PG8_SA(b, h) + aoff + m * 2048 + k * 1024); } while (0)
#define PG8_LDB(dst, b, h) do { _Pragma("unroll") for (int n = 0; n < 2; ++n) _Pragma("unroll") for (int k = 0; k < 2; ++k) dst[n][k] = *(const LAS bf16x8*)(lds + PG8_SB(b, h) + boff + n * 2048 + k * 1024); } while (0)
    int fscale = 124; asm volatile("" : "+v"(fscale));
#define PG8_MMA(ai, bj, At, Bt) do { __builtin_amdgcn_s_setprio(1); _Pragma("unroll") for (int m = 0; m < 4; ++m) _Pragma("unroll") for (int n = 0; n < 2; ++n) { \
        if constexpr (FP8) { const i32x8 b8_ = __builtin_shufflevector(__builtin_bit_cast(i32x4, Bt[n][0]), __builtin_bit_cast(i32x4, Bt[n][1]), 0, 1, 2, 3, 4, 5, 6, 7), \
                a8_ = __builtin_shufflevector(__builtin_bit_cast(i32x4, At[m][0]), __builtin_bit_cast(i32x4, At[m][1]), 0, 1, 2, 3, 4, 5, 6, 7); \
            asm volatile("v_mfma_scale_f32_16x16x128_f8f6f4 %0, %1, %2, %0, %3, %3 op_sel_hi:[0,0,0]" : "+v"(acc[ai][bj][m][n]) : "v"(b8_), "v"(a8_), "v"(fscale)); } \
        else { _Pragma("unroll") for (int k = 0; k < 2; ++k) acc[ai][bj][m][n] = __builtin_amdgcn_mfma_f32_16x16x32_bf16(Bt[n][k], At[m][k], acc[ai][bj][m][n], 0, 0, 0); } } \
        __builtin_amdgcn_s_setprio(0); } while (0)
#define PG8_WAIT_V(n) asm volatile("s_waitcnt vmcnt(" #n ")" ::: "memory")
#define PG8_WAIT_L(n) asm volatile("s_waitcnt lgkmcnt(" #n ")" ::: "memory")
#define PG8_BAR __builtin_amdgcn_s_barrier()
#define PG8_SCHED __builtin_amdgcn_sched_barrier(0)
    const unsigned stash = 131072u + (unsigned)tid * 32u; int cs = 0;
#define PG8_GATHER_OFFS(slot_, row0_) do { int gi_[2][2]; \
        _Pragma("unroll") for (int h_ = 0; h_ < 2; ++h_) _Pragma("unroll") for (int i_ = 0; i_ < 2; ++i_) { int R_, C_; stage_rc(tid * 16 + i_ * 8192, R_, C_); gi_[h_][i_] = ((const int*)d.gidx)[(row0_) + h_ * HALF + R_]; } \
        asm volatile("s_waitcnt vmcnt(0)" ::: "memory"); u32x4 o_; \
        { int R_, C_; stage_rc(tid * 16, R_, C_); o_.x = (unsigned)(gi_[0][0] * d.lda + C_) * 2u; o_.z = (unsigned)(gi_[1][0] * d.lda + C_) * 2u; } \
        { int R_, C_; stage_rc(tid * 16 + 8192, R_, C_); o_.y = (unsigned)(gi_[0][1] * d.lda + C_) * 2u; o_.w = (unsigned)(gi_[1][1] * d.lda + C_) * 2u; } \
        *(LAS u32x4*)(lds + stash + (slot_) * 16) = o_; } while (0)
#define PG8_STAGE(bufoff, rsrc, soff, voff) do { _Pragma("unroll") for (int _i = 0; _i < 2; ++_i) \
        __builtin_amdgcn_raw_ptr_buffer_load_lds(rsrc, (LAS unsigned*)(lds + (bufoff) + ldsw + _i * 8192), 16, (voff)[_i], (soff), 0, 0); } while (0)
#define PG8_STAGE_G(bufoff, soff, slot_, h_) do { const u32x2 o_ = *(const LAS u32x2*)(lds + stash + (slot_) * 16 + (h_) * 8); \
        __builtin_amdgcn_raw_ptr_buffer_load_lds(rsrcA, (LAS unsigned*)(lds + (bufoff) + ldsw), 16, o_.x, (soff), 0, 0); \
        __builtin_amdgcn_raw_ptr_buffer_load_lds(rsrcA, (LAS unsigned*)(lds + (bufoff) + ldsw + 8192), 16, o_.y, (soff), 0, 0); } while (0)
#define PG8_STAGE_A(bufoff, soff, slot_, h_) do { if constexpr (GATHER) PG8_STAGE_G(bufoff, soff, slot_, h_); else PG8_STAGE(bufoff, rsrcA, (soff) + (h_) * hstepA, voffA); } while (0)
#define PG8_STAGE_B(bufoff, soff) PG8_STAGE(bufoff, rsrcB, soff, voffB)
    const __amdgpu_buffer_rsrc_t rsrcA = __builtin_amdgcn_make_buffer_rsrc((void*)d.A, 0, 0x7fffffff, 0x00020000), rsrcB = __builtin_amdgcn_make_buffer_rsrc((void*)d.B, 0, 0x7fffffff, 0x00020000);
    Unit cur, nxt; int ui = 0;
    if (!unit_next(d, 0, G, c, cur)) return;
    f32x4 acc[2][2][4][2];
#pragma unroll
    for (int a = 0; a < 2; ++a)
#pragma unroll
        for (int b = 0; b < 2; ++b)
#pragma unroll
            for (int m = 0; m < 4; ++m)
#pragma unroll
                for (int n = 0; n < 2; ++n) acc[a][b][m][n] = (f32x4){0.f, 0.f, 0.f, 0.f};
    bf16x8 At[4][2], B0[2][2], B1[2][2];
    unsigned cA = cur.A, cB = cur.B;
    if constexpr (GATHER) PG8_GATHER_OFFS(cs, cur.row0);
    PG8_STAGE_B(PG8_SB(0, 0), cB); PG8_STAGE_B(PG8_SB(0, 1), cB + hstepB); PG8_STAGE_A(PG8_SA(0, 0), cA, cs, 0); PG8_STAGE_A(PG8_SA(0, 1), cA, cs, 1);
    if (wr == 1) PG8_BAR;
    PG8_WAIT_V(2); PG8_BAR;
    PG8_STAGE_B(PG8_SB(1, 0), cB + kstep); PG8_STAGE_A(PG8_SA(1, 0), cA + kstep, cs, 0); PG8_STAGE_B(PG8_SB(1, 1), cB + hstepB + kstep);
    PG8_WAIT_V(6); PG8_BAR;
    for (;;) {
        const bool has_next = unit_next(d, ui + 1, G, c, nxt);
        const unsigned nA = has_next ? nxt.A : cA, nB = has_next ? nxt.B : cB;
        if constexpr (GATHER) { if (has_next) PG8_GATHER_OFFS(cs ^ 1, nxt.row0); else { const u32x4 o_ = *(const LAS u32x4*)(lds + stash + cs * 16); *(LAS u32x4*)(lds + stash + (cs ^ 1) * 16) = o_; } }
        for (int t = 0; t < nt; t += 2) {
            const bool last = (t == nt - 2);
            const unsigned a1 = cA + (unsigned)(t + 1) * kstep;
            const unsigned a2 = last ? nA : cA + (unsigned)(t + 2) * kstep, b2 = last ? nB : cB + (unsigned)(t + 2) * kstep;
            const unsigned a3 = a2 + kstep, b3 = b2 + kstep;
            const int ns = last ? (cs ^ 1) : cs;
            if constexpr (HOOK) { if (d.hook_t == t) { midk_scale(d, acc, cur, wr, wc, fr, fq); } }
            PG8_LDB(B0, 0, 0); PG8_LDB(B1, 0, 1); PG8_SCHED; PG8_LDA(At, 0, 0); PG8_STAGE_A(PG8_SA(1, 1), a1, cs, 1);
            PG8_WAIT_V(8); PG8_WAIT_L(0); PG8_BAR; PG8_MMA(0, 0, At, B0); PG8_MMA(0, 1, At, B1); PG8_BAR; PG8_SCHED;
            PG8_LDA(At, 0, 1); PG8_STAGE_B(PG8_SB(0, 0), b2); PG8_STAGE_B(PG8_SB(0, 1), b2 + hstepB); PG8_STAGE_A(PG8_SA(0, 0), a2, ns, 0);
            PG8_WAIT_V(8); PG8_WAIT_L(0); PG8_BAR; PG8_MMA(1, 0, At, B0); PG8_MMA(1, 1, At, B1); PG8_BAR; PG8_SCHED;
            PG8_LDB(B0, 1, 0); PG8_LDB(B1, 1, 1); PG8_SCHED; PG8_LDA(At, 1, 0); PG8_STAGE_A(PG8_SA(0, 1), a2, ns, 1);
            PG8_WAIT_V(8); PG8_WAIT_L(0); PG8_BAR; PG8_MMA(0, 0, At, B0); PG8_MMA(0, 1, At, B1); PG8_BAR; PG8_SCHED;
            PG8_LDA(At, 1, 1); PG8_STAGE_B(PG8_SB(1, 0), b3); PG8_STAGE_B(PG8_SB(1, 1), b3 + hstepB); PG8_STAGE_A(PG8_SA(1, 0), a3, ns, 0);
            PG8_WAIT_V(8); PG8_WAIT_L(0); PG8_BAR; PG8_MMA(1, 0, At, B0); PG8_MMA(1, 1, At, B1); PG8_BAR; PG8_SCHED;
        }
        if (wr == 0) PG8_BAR;
        if constexpr (FP8) asm volatile("s_nop 15\n\ts_nop 15" ::: "memory");
        epilogue(d, acc, cur, wr, wc, fr, fq);
        if (!has_next) break;
#pragma unroll
        for (int a = 0; a < 2; ++a)
#pragma unroll
            for (int b = 0; b < 2; ++b)
#pragma unroll
                for (int m = 0; m < 4; ++m)
#pragma unroll
                    for (int n = 0; n < 2; ++n) acc[a][b][m][n] = (f32x4){0.f, 0.f, 0.f, 0.f};
        cur = nxt; cA = nA; cB = nB; ++ui;
        if constexpr (GATHER) cs ^= 1;
        if (wr == 1) PG8_BAR;
    }
    PG8_WAIT_V(0);
    PG8_BAR;
#undef PG8_SA
#undef PG8_SB
#undef PG8_STAGE
#undef PG8_LDA
#undef PG8_LDB
#undef PG8_MMA
#undef PG8_WAIT_V
#undef PG8_WAIT_L
#undef PG8_BAR
#undef PG8_SCHED
#undef PG8_GATHER_OFFS
#undef PG8_STAGE_G
#undef PG8_STAGE_A
#undef PG8_STAGE_B
}

struct Args { const float* in[17]; float* out; unsigned char* ws; int ph_lo, ph_hi; };
enum In { I_X = 0, I_NMIX, I_WIN, I_WFM, I_WPM, I_PSCALE, I_WBF, I_WBP, I_WGATE, I_BGATE, I_WOUT, I_NMOE, I_WROUTER, I_WEG, I_WEU, I_WED, I_NFINAL };

enum GemmId { G_MGU = 0, G_MGV, G_MGP, G_1A, G_1B, G_1C, G_DFTU, G_DFTV, G_4, G_OUT, G_GU, G_DOWN };
__device__ __forceinline__ void make_desc(int id, const Args& a, GemmDesc& d) {
    unsigned char* ws = a.ws;
    d.sAz = 0; d.sBz = 0; d.rz = 0; d.rm = BM; d.nZ = 1; d.coff = 0; d.oz = 0; d.P1 = nullptr; d.P2 = nullptr; d.perm = 1; d.mode = EPI_STORE; d.hook_t = -1; d.gidx = nullptr;
    switch (id) {
    case G_MGU:
    case G_MGV:
    case G_MGP:
        d.A = (const char*)(ws + (id == G_MGP ? WS_WBPT : WS_WBFT)); d.lda = FW; d.B = (const char*)(ws + (id == G_MGU ? WS_MIXC : id == G_MGV ? WS_MIXS : WS_MIXP)); d.ldb = 256; d.K = 256; d.nM = 8; d.nN = 1; d.nZ = 4;
        d.sAz = 256 * 2; d.sAm = (long)BM * FW * 2; d.sBz = 256 * 256 * 2; d.sBn = 0; d.O = ws + WS_WUVP + (size_t)(id - G_MGU) * FW * 2; d.ldc = UVZ; d.oz = 256; d.coff = 32 * (id - G_MGU); break;
    case G_1A:
        d.A = (const char*)(ws + WS_WTIN); d.lda = D; d.B = (const char*)(ws + WS_RA); d.ldb = D; d.K = D; d.nM = 4; d.nN = 8; d.nZ = 8;
        d.sAm = (long)BM * D * 2; d.sBz = (long)SEQ * D * 2; d.sBn = (long)BM * D * 2; d.O = ws + WS_RB; d.ldc = SEQ; d.oz = (long)FW * SEQ; break;
    case G_1B:
        d.A = (const char*)(ws + WS_RA); d.lda = D; d.B = (const char*)(ws + WS_WTIN + (size_t)FW * D * 2); d.ldb = D; d.K = D; d.nM = T / BM; d.nN = 4;
        d.sAm = (long)BM * D * 2; d.sBn = (long)BM * D * 2; d.mode = EPI_PG; d.perm = 1; d.O = ws + WS_RC; d.ldc = FW; d.P1 = ws + WS_RD; d.P2 = a.in[I_BGATE]; break;
    case G_1C:
        d.A = (const char*)(ws + WS_RE); d.lda = D / 2; d.B = (const char*)(ws + WS_WTG); d.ldb = D / 2; d.K = D / 2; d.nM = T / BM; d.nN = 16;
        d.sAm = (long)BM * D; d.sBn = (long)BM * D; d.mode = EPI_PG; d.perm = 0; d.O = ws + WS_RC; d.ldc = FW; d.P1 = ws + WS_RD; d.P2 = a.in[I_BGATE]; break;
    case G_DFTU:
    case G_DFTV:
        { const int ku = (id == G_DFTU ? KU : FW);
        d.A = (const char*)(ws + (id == G_DFTU ? WS_TC : WS_TS)); d.lda = ku; d.B = (const char*)(ws + (id == G_DFTU ? WS_PP : WS_PM)); d.ldb = ku; d.K = ku; d.nM = 4; d.nN = 4; d.nZ = 8;
        d.sAm = (long)BM * ku * 2; d.sBz = (long)FW * ku * 2; d.sBn = (long)BM * ku * 2; d.rz = SEQ; d.mode = EPI_MIRROR; d.O = ws + WS_RE + (id == G_DFTV ? FW * 2 : 0); d.ldc = UVZ; d.oz = (id == G_DFTV); d.coff = (id == G_DFTV ? 128 : 0); }
        break;
    case G_4:
        d.A = (const char*)(ws + WS_RE); d.lda = UVZ; d.B = (const char*)(ws + WS_WUVP); d.ldb = UVZ; d.K = KUVZ; d.nM = T / BM; d.nN = 8;
        d.sAm = (long)BM * UVZ * 2; d.sBn = (long)BM * UVZ * 2; d.mode = EPI_GATED; d.O = ws + WS_RA; d.ldc = D; d.hook_t = (2 * FW / BK);
        d.P1 = ws + WS_RD + (size_t)T * D * 2; d.P2 = ws + WS_RD; break;
    case G_OUT:
        d.A = (const char*)(ws + WS_RA); d.lda = D; d.B = (const char*)(ws + WS_WOUT); d.ldb = D; d.K = D; d.nM = T / BM; d.nN = 8;
        d.sAm = (long)BM * D * 2; d.sBn = (long)BM * D * 2; d.mode = EPI_STORE; d.O = a.out; d.ldc = 2 * D; break;
    case G_GU:
        d.A = (const char*)(ws + WS_RA); d.lda = D / 2; d.B = (const char*)(ws + WS_WGU); d.ldb = D / 2; d.K = D / 2; d.nM = BATCH; d.nN = 11; d.nZ = NE;
        d.sAz = 0; d.sAm = (long)SEQ * D; d.sBz = (long)2 * FF * D; d.sBn = (long)BM * D; d.rz = BM; d.rm = NE * BM;
        d.mode = EPI_SWIGLU; d.perm = 0; d.O = ws + WS_RB; d.ldc = FF; d.gidx = ws + WS_IDX; break;
    default:
        d.A = (const char*)(ws + WS_RB); d.lda = HP / 2; d.B = (const char*)(ws + WS_WD); d.ldb = HP / 2; d.K = HP / 2; d.nM = BATCH; d.nN = 8; d.nZ = NE;
        d.sAz = (long)BM * HP; d.sAm = (long)NE * BM * HP; d.sBz = (long)D * HP; d.sBn = (long)BM * HP; d.rz = BM; d.rm = NE * BM;
        d.mode = EPI_ROWSCALE; d.O = ws + WS_RD; d.ldc = D; d.P1 = ws + WS_GATE; break;
    }
}

__device__ __forceinline__ void transpose_tile(const float* src, int ldw, bf16_t* dbase, int ldt, int il, LAS float* scr, int lane) {
    (void)scr; (void)il;
    f32x4 v[16]; const int kb = lane >> 4, n4 = 4 * (lane & 15);
#pragma unroll
    for (int j = 0; j < 16; ++j) v[j] = *(const f32x4*)(src + (size_t)(16 * kb + j) * ldw + n4);
#pragma unroll
    for (int i = 0; i < 4; ++i) { u32x4 o0, o1;
        o0.x = cvt_pk_bf16(v[0][i], v[1][i]); o0.y = cvt_pk_bf16(v[2][i], v[3][i]); o0.z = cvt_pk_bf16(v[4][i], v[5][i]); o0.w = cvt_pk_bf16(v[6][i], v[7][i]);
        o1.x = cvt_pk_bf16(v[8][i], v[9][i]); o1.y = cvt_pk_bf16(v[10][i], v[11][i]); o1.z = cvt_pk_bf16(v[12][i], v[13][i]); o1.w = cvt_pk_bf16(v[14][i], v[15][i]);
        bf16_t* rp = dbase + (size_t)(n4 + i) * ldt + 16 * kb; *(u32x4*)rp = o0; *(u32x4*)(rp + 8) = o1; }
}

__device__ __forceinline__ void transpose_tile_f8(const float* src, int ldw, unsigned char* dmat, int ldt, int n0, int il, int up16, float scale, LAS float* scr, int lane) {
    (void)scr;
    f32x4 v[16]; const int kb = lane >> 3, n4 = 4 * (lane & 7);
#pragma unroll
    for (int j = 0; j < 16; ++j) v[j] = *(const f32x4*)(src + (size_t)(16 * kb + j) * ldw + n4);
#pragma unroll
    for (int i = 0; i < 4; ++i) { i32x4 o;
#pragma unroll
        for (int q = 0; q < 4; ++q) { int w = 0; w = __builtin_amdgcn_cvt_pk_fp8_f32(v[4 * q][i] * scale, v[4 * q + 1][i] * scale, w, false); w = __builtin_amdgcn_cvt_pk_fp8_f32(v[4 * q + 2][i] * scale, v[4 * q + 3][i] * scale, w, true); o[q] = w; }
        const int hn = n0 + n4 + i; const int dd_ = hn & 127;
        const int ro = il == 1 ? ((hn >> 7) * 256 + ((hn >> 6) & 1) * 128 + ((hn >> 4) & 3) * 32 + (hn & 15) + up16)
                     : il == 2 ? (((hn & 2047) >> 7) * 256 + 128 * ((dd_ >> 2) & 1) + 32 * (dd_ >> 5) + 16 * (hn >> 11) + 4 * ((dd_ >> 3) & 3) + (dd_ & 3)) : hn;
        *(i32x4*)(dmat + (size_t)ro * ldt + 16 * kb) = o; }
}

__device__ __forceinline__ void p0_items(const Args& a, LAS unsigned char* lds, int gw, int NGW, int wave, int lane, int it_lo, int it_hi) {
    unsigned char* ws = a.ws;
    LAS float* scr = (LAS float*)(lds + wave * (64 * 68 * 4));
    constexpr int I0 = 1024, I1 = 2048, I2 = 512, I3 = 512, I4 = 1024, IE = 16 * 704;
    constexpr int NITEMS = I0 + I1 + I2 + I3 + I4 + 3 * IE;
    (void)NITEMS;
    for (int it = it_lo + gw; it < it_hi; it += NGW) {
        int r = it; const float* src; int ldw, ldt, il = 0; bf16_t* db;
        if (r < I0) { const int kb = r / 32, nb = r % 32; src = a.in[I_WIN] + (size_t)(64 * kb) * D + 64 * nb; ldw = D; ldt = D; db = (bf16_t*)(ws + WS_WTIN) + (size_t)(64 * nb) * D + 64 * kb; }
        else if ((r -= I0) < I1) { const int kb = r / 128, nb = r % 128;
            transpose_tile_f8(a.in[I_WGATE] + (size_t)(128 * kb) * (2 * D) + 32 * nb, 2 * D, ws + WS_WTG + 128 * kb, D, 32 * nb, 2, 0, 64.0f, scr, lane); continue; }
        else if ((r -= I1) < I2) { const int kb = r / 32, nb = r % 32; src = a.in[I_WBF] + (size_t)(64 * kb) * D + 64 * nb; ldw = D; ldt = FW; db = (bf16_t*)(ws + WS_WBFT) + (size_t)(64 * nb) * FW + 64 * kb; }
        else if ((r -= I2) < I3) { const int kb = r / 32, nb = r % 32; src = a.in[I_WBP] + (size_t)(64 * kb) * D + 64 * nb; ldw = D; ldt = FW; db = (bf16_t*)(ws + WS_WBPT) + (size_t)(64 * nb) * FW + 64 * kb; }
        else if ((r -= I3) < I4) { const int kb = r / 32, nb = r % 32; src = a.in[I_WOUT] + (size_t)(64 * kb) * D + 64 * nb; ldw = D; ldt = D; db = (bf16_t*)(ws + WS_WOUT) + (size_t)(64 * nb) * D + 64 * kb; }
        else if ((r -= I4) < 2 * IE) { const int up = r >= IE; if (up) r -= IE; const int e = r / 704, q = r % 704, kb = q / 44, nb = q % 44;
            src = (up ? a.in[I_WEU] : a.in[I_WEG]) + (size_t)e * D * FF + (size_t)(128 * kb) * FF + 32 * nb;
            transpose_tile_f8(src, FF, ws + WS_WGU + (size_t)e * 2 * FF * D + 128 * kb, D, 32 * nb, 1, 16 * up, 64.0f, scr, lane); continue; }
        else { r -= 2 * IE; const int e = r / 704, q = r % 704, kb = q / 64, nb = q % 64;
            transpose_tile_f8(a.in[I_WED] + (size_t)e * FF * D + (size_t)(128 * kb) * D + 32 * nb, D, ws + WS_WD + (size_t)e * D * HP + 128 * kb, HP, 32 * nb, 0, 0, 64.0f, scr, lane); continue; }
        transpose_tile(src, ldw, db, ldt, il, scr, lane);
    }
}
constexpr int P0_NBASE = 1024 + 2048 + 512 + 512, P0_NITEMS = P0_NBASE + 1024 + 3 * 16 * 704;
__device__ __forceinline__ void p0_prologue(const Args& a, LAS unsigned char* lds, int gw, int NGW, int wave, int lane) {
    unsigned char* ws = a.ws;
    p0_items(a, lds, gw, NGW, wave, lane, 0, P0_NBASE);
    const int gt = gw * 64 + lane, NGT = NGW * 64;
    for (int i = gt; i < FW * 256 / 4; i += NGT) { const f32x4 v = *(const f32x4*)(a.in[I_WPM] + 4 * (size_t)i);
        const int g = i / (256 * 64), c2 = (i % 64) * 4; const f32x4 sc = *(const f32x4*)(a.in[I_PSCALE] + g * 256 + c2);
        u32x2 o; o.x = pk2(v[0] * sc[0], v[1] * sc[1]); o.y = pk2(v[2] * sc[2], v[3] * sc[3]); *(u32x2*)((bf16_t*)(ws + WS_MIXP) + 4 * (size_t)i) = o; }
    { LAS float* ct = (LAS float*)(lds + 147456);
        for (int i = lane + 64 * wave; i < 256; i += 64 * NWAVES) ct[i] = cospif((float)i * (1.0f / 128.0f));
        LDS_WAIT(); __syncthreads();
        for (int i = gt; i < 4 * 256 * 64; i += NGT) { const int c2 = (i & 63) * 4, cp = (i >> 6) & 255, g = i >> 14; const float* w = a.in[I_WFM] + (size_t)g * 65536 + c2;
            f32x4 sc_ = {0.f, 0.f, 0.f, 0.f}, ss_ = {0.f, 0.f, 0.f, 0.f};
#pragma unroll 8
            for (int c = 0; c < 256; ++c) { const f32x4 wv = *(const f32x4*)(w + (size_t)c * 256); const int ph = (c * cp) & 255; sc_ += wv * ct[ph]; ss_ += wv * ct[(ph - 64) & 255]; }
            const size_t o = (size_t)g * 65536 + (size_t)cp * 256 + c2;
            u32x2 oc; oc.x = pk2(sc_[0] * 0.0625f, sc_[1] * 0.0625f); oc.y = pk2(sc_[2] * 0.0625f, sc_[3] * 0.0625f); *(u32x2*)((bf16_t*)(ws + WS_MIXC) + o) = oc;
            u32x2 os; os.x = pk2(-ss_[0] * 0.0625f, -ss_[1] * 0.0625f); os.y = pk2(-ss_[2] * 0.0625f, -ss_[3] * 0.0625f); *(u32x2*)((bf16_t*)(ws + WS_MIXS) + o) = os; } }
    for (int i = gt; i < NE * D * 8; i += NGT) *(i32x4*)(ws + WS_WD + (size_t)(i >> 3) * HP + FF + 16 * (i & 7)) = (i32x4){0, 0, 0, 0};
    for (int i = gt; i < FW * KU / 2; i += NGT) { const int k = i / (KU / 2), n = (i % (KU / 2)) * 2; float o2[2];
#pragma unroll
        for (int q = 0; q < 2; ++q) { const int ph = (k * (n + q)) & (SEQ - 1); o2[q] = (n + q <= FW) ? cospif((float)ph * (1.0f / 1024.0f)) * 0.02209708691207961f : 0.f; }
        *(unsigned*)((bf16_t*)(ws + WS_TC) + (size_t)k * KU + n) = pk2(o2[0], o2[1]); }
    for (int i = gt; i < FW * FW / 2; i += NGT) { const int k = i / (FW / 2), n = (i % (FW / 2)) * 2; float o2[2];
#pragma unroll
        for (int q = 0; q < 2; ++q) { const int ph = (k * (n + q)) & (SEQ - 1); o2[q] = sinpif((float)ph * (1.0f / 1024.0f)) * 0.02209708691207961f; }
        *(unsigned*)((bf16_t*)(ws + WS_TS) + (size_t)k * FW + n) = pk2(o2[0], o2[1]); }
    const float* gm = a.in[I_NMIX];
    for (int m = gw; m < T; m += NGW) { const f32x4* xr = (const f32x4*)(a.in[I_X] + (size_t)m * D) + lane; f32x4 v[8]; float s = 0.f;
#pragma unroll
        for (int j = 0; j < 8; ++j) { v[j] = __builtin_nontemporal_load(xr + 64 * j); s += (v[j][0] * v[j][0] + v[j][1] * v[j][1]) + (v[j][2] * v[j][2] + v[j][3] * v[j][3]); }
        const float rstd = 1.0f / sqrtf(wave_sum(s) * (1.0f / D) + EPS);
        u32x2* o8 = (u32x2*)((bf16_t*)(ws + WS_RA) + (size_t)m * D) + lane; unsigned* o4 = (unsigned*)(ws + WS_RE + (size_t)m * D) + lane;
#pragma unroll
        for (int j = 0; j < 8; ++j) { const f32x4 g = ((const f32x4*)gm)[lane + 64 * j]; const f32x4 uv = v[j] * g * rstd; u32x2 o; o.x = pk2(uv[0], uv[1]); o.y = pk2(uv[2], uv[3]); o8[64 * j] = o;
            int w = 0; w = __builtin_amdgcn_cvt_pk_fp8_f32(uv[0], uv[1], w, false); w = __builtin_amdgcn_cvt_pk_fp8_f32(uv[2], uv[3], w, true); o4[64 * j] = (unsigned)w; } }
}

__device__ __forceinline__ void p3_fold(const Args& a, int gw, int NGW, int lane) {
    const bf16_t* PT = (const bf16_t*)(a.ws + WS_RB); bf16_t* PP = (bf16_t*)(a.ws + WS_PP); bf16_t* PM = (bf16_t*)(a.ws + WS_PM); bf16_t* Z = (bf16_t*)(a.ws + WS_RE);
    for (int row = gw; row < BATCH * FW; row += NGW) { const bf16_t* p = PT + (size_t)row * SEQ;
        u32x4 X[2], M[2]; unsigned E[2];
#pragma unroll
        for (int j = 0; j < 2; ++j) { const int n0 = 8 * lane + 512 * j; X[j] = *(const u32x4*)(p + n0); M[j] = *(const u32x4*)(p + 2040 - n0); E[j] = (n0 > 0) ? (unsigned)p[SEQ - n0] : 0u; }
        const float xm = bf_lo((unsigned)p[FW]); float alt = 0.f;
#pragma unroll
        for (int j = 0; j < 2; ++j) { const int n0 = 8 * lane + 512 * j;
            float x[8], m[8], y[8]; x[0] = bf_lo(X[j].x); x[1] = bf_hi(X[j].x); x[2] = bf_lo(X[j].y); x[3] = bf_hi(X[j].y); x[4] = bf_lo(X[j].z); x[5] = bf_hi(X[j].z); x[6] = bf_lo(X[j].w); x[7] = bf_hi(X[j].w);
            m[0] = bf_lo(M[j].x); m[1] = bf_hi(M[j].x); m[2] = bf_lo(M[j].y); m[3] = bf_hi(M[j].y); m[4] = bf_lo(M[j].z); m[5] = bf_hi(M[j].z); m[6] = bf_lo(M[j].w); m[7] = bf_hi(M[j].w);
            y[0] = bf_lo(E[j]);
#pragma unroll
            for (int i = 1; i < 8; ++i) y[i] = m[8 - i];
            float sp[8], sm[8];
#pragma unroll
            for (int i = 0; i < 8; ++i) { sp[i] = x[i] + y[i]; sm[i] = x[i] - y[i]; alt += (i & 1) ? -sp[i] : sp[i]; }
            if (n0 == 0) sm[0] = 0.f;
            u32x4 wp, wm; wp.x = pk2(sp[0], sp[1]); wp.y = pk2(sp[2], sp[3]); wp.z = pk2(sp[4], sp[5]); wp.w = pk2(sp[6], sp[7]); wm.x = pk2(sm[0], sm[1]); wm.y = pk2(sm[2], sm[3]); wm.z = pk2(sm[4], sm[5]); wm.w = pk2(sm[6], sm[7]);
            *(u32x4*)(PP + (size_t)row * KU + n0) = wp; *(u32x4*)(PM + (size_t)row * FW + n0) = wm; }
        if (lane < 16) { u32x4 t = {0u, 0u, 0u, 0u}; if (lane == 0) t.x = f2bf(xm); *(u32x4*)(PP + (size_t)row * KU + FW + 8 * lane) = t; }
        alt = wave_sum(alt) + xm;
        if (lane == 0) { const int b = row >> 10, c = row & (FW - 1); Z[(size_t)(b * SEQ + FW) * UVZ + c] = (bf16_t)f2bf(alt * 0.02209708691207961f); Z[(size_t)(b * SEQ + FW) * UVZ + FW + c] = 0; } }
}

__device__ __forceinline__ void ld8(const bf16_t* p, float (&f)[8]) { const u32x4 w = *(const u32x4*)p; f[0] = bf_lo(w.x); f[1] = bf_hi(w.x); f[2] = bf_lo(w.y); f[3] = bf_hi(w.y); f[4] = bf_lo(w.z); f[5] = bf_hi(w.z); f[6] = bf_lo(w.w); f[7] = bf_hi(w.w); }
__device__ __forceinline__ void p3_pool(const Args& a, int gtid, int NGT) {
    const bf16_t* P = (const bf16_t*)(a.ws + WS_RC); bf16_t* Z = (bf16_t*)(a.ws + WS_RE);
    for (int idx = gtid; idx < BATCH * 128 * 128; idx += NGT) {
        const int cb = idx & 127, chunk = (idx >> 7) & 127, b = idx >> 14, half = 1 << (cb >> 5), i0 = chunk * 16;
        const bf16_t* Pb = P + (size_t)b * SEQ * FW + cb * 8;
        float sum[8];
#pragma unroll
        for (int q = 0; q < 8; ++q) sum[q] = 0.f;
        { u32x4 w[16];
#pragma unroll
          for (int k = 0; k < 16; ++k) { int r = i0 - half + k; r = r < 0 ? 0 : (r > SEQ - 1 ? SEQ - 1 : r); w[k] = *(const u32x4*)(Pb + (size_t)r * FW); }
#pragma unroll
          for (int k = 0; k < 16; ++k) { const int r = i0 - half + k; const float mk = (k < 2 * half && r >= 0 && r < SEQ) ? 1.f : 0.f;
              sum[0] += mk * bf_lo(w[k].x); sum[1] += mk * bf_hi(w[k].x); sum[2] += mk * bf_lo(w[k].y); sum[3] += mk * bf_hi(w[k].y); sum[4] += mk * bf_lo(w[k].z); sum[5] += mk * bf_hi(w[k].z); sum[6] += mk * bf_lo(w[k].w); sum[7] += mk * bf_hi(w[k].w); } }
#pragma unroll 1
        for (int g4 = 0; g4 < 4; ++g4) { const int ib = i0 + 4 * g4; u32x4 ws_[4], wa[4], wb[4];
#pragma unroll
            for (int t = 0; t < 4; ++t) { const int i = ib + t; int ra = i + half; ra = ra > SEQ - 1 ? SEQ - 1 : ra; int rb = i - half; rb = rb < 0 ? 0 : rb;
                ws_[t] = *(const u32x4*)(Pb + (size_t)i * FW); wa[t] = *(const u32x4*)(Pb + (size_t)ra * FW); wb[t] = *(const u32x4*)(Pb + (size_t)rb * FW); }
#pragma unroll
            for (int t = 0; t < 4; ++t) { const int i = ib + t;
                int l2 = i - half; if (l2 < 0) l2 = 0; int h2 = i + half; if (h2 > SEQ) h2 = SEQ;
                const float inv = 1.0f / (float)(h2 - l2);
                const float f[8] = {bf_lo(ws_[t].x), bf_hi(ws_[t].x), bf_lo(ws_[t].y), bf_hi(ws_[t].y), bf_lo(ws_[t].z), bf_hi(ws_[t].z), bf_lo(ws_[t].w), bf_hi(ws_[t].w)}; float o[8];
#pragma unroll
                for (int q = 0; q < 8; ++q) o[q] = sum[q] * inv - f[q];
                u32x4 w; w.x = pk2(o[0], o[1]); w.y = pk2(o[2], o[3]); w.z = pk2(o[4], o[5]); w.w = pk2(o[6], o[7]);
                *(u32x4*)(Z + (size_t)(b * SEQ + i) * UVZ + 2 * FW + cb * 8) = w;
                const float ma = (i + half < SEQ) ? 1.f : 0.f, mb = (i - half >= 0) ? 1.f : 0.f;
                sum[0] += ma * bf_lo(wa[t].x) - mb * bf_lo(wb[t].x); sum[1] += ma * bf_hi(wa[t].x) - mb * bf_hi(wb[t].x); sum[2] += ma * bf_lo(wa[t].y) - mb * bf_lo(wb[t].y); sum[3] += ma * bf_hi(wa[t].y) - mb * bf_hi(wb[t].y);
                sum[4] += ma * bf_lo(wa[t].z) - mb * bf_lo(wb[t].z); sum[5] += ma * bf_hi(wa[t].z) - mb * bf_hi(wb[t].z); sum[6] += ma * bf_lo(wa[t].w) - mb * bf_lo(wb[t].w); sum[7] += ma * bf_hi(wa[t].w) - mb * bf_hi(wb[t].w); } }
    }
}

__device__ __forceinline__ float reduce16(const float (&a)[16], int lane) {
    float b8[8], b4[4], b2[2];
    { const bool hi = lane & 32;
#pragma unroll
      for (int i = 0; i < 8; ++i) { const float snd = hi ? a[i] : a[i + 8], kp = hi ? a[i + 8] : a[i]; b8[i] = kp + __shfl_xor(snd, 32); } }
    { const bool hi = lane & 16;
#pragma unroll
      for (int i = 0; i < 4; ++i) { const float snd = hi ? b8[i] : b8[i + 4], kp = hi ? b8[i + 4] : b8[i]; b4[i] = kp + __shfl_xor(snd, 16); } }
    { const bool hi = lane & 8;
#pragma unroll
      for (int i = 0; i < 2; ++i) { const float snd = hi ? b4[i] : b4[i + 2], kp = hi ? b4[i + 2] : b4[i]; b2[i] = kp + __shfl_xor(snd, 8); } }
    const bool hi = lane & 4; const float snd = hi ? b2[0] : b2[1], kp = hi ? b2[1] : b2[0]; float r = kp + __shfl_xor(snd, 4);
    r += __shfl_xor(r, 2); r += __shfl_xor(r, 1);
    return r;
}
__device__ __forceinline__ void p6_rows(const Args& a, LAS unsigned char* lds, int gw, int NGW, int lane, int tid) {
    LAS float* wt = (LAS float*)lds;
    for (int i = tid; i < D * NE / 4; i += NTHR) { const int dd = i & (D - 1), eq = i >> 11; const f32x4 v = *(const f32x4*)(a.in[I_WROUTER] + (size_t)dd * NE + 4 * eq);
#pragma unroll
        for (int q = 0; q < 4; ++q) wt[(4 * eq + q) * D + dd] = v[q]; }
    LDS_WAIT(); __syncthreads();
    const float* gm = a.in[I_NMOE]; unsigned char* V = (unsigned char*)(a.ws + WS_RA); float* AFF = (float*)(a.ws + WS_AFF);
    for (int i = gw * 64 + lane; i < NPAN * CAP * 8; i += NGW * 64) *(i32x4*)(a.ws + WS_RB + (size_t)(i >> 3) * HP + FF + 16 * (i & 7)) = (i32x4){0, 0, 0, 0};
    const int eL = ((lane >> 5) & 1) * 8 + ((lane >> 4) & 1) * 4 + ((lane >> 3) & 1) * 2 + ((lane >> 2) & 1);
#pragma unroll 1
    for (int m0 = gw; m0 < T; m0 += 2 * NGW) {
        f32x4 v[2][8]; u32x2 dl[2][8];
#pragma unroll
        for (int r = 0; r < 2; ++r) { const int m = min(m0 + r * NGW, T - 1); const f32x4* xr = (const f32x4*)(a.in[I_X] + (size_t)m * D) + lane; const u32x2* dr = (const u32x2*)(a.out + (size_t)m * D) + lane;
#pragma unroll
            for (int j = 0; j < 8; ++j) { v[r][j] = __builtin_nontemporal_load(xr + 64 * j); dl[r][j] = dr[64 * j]; } }
#pragma unroll
        for (int r = 0; r < 2; ++r) { float s = 0.f;
#pragma unroll
            for (int j = 0; j < 8; ++j) { const u32x2 w = dl[r][j]; v[r][j][0] += bf_lo(w.x); v[r][j][1] += bf_hi(w.x); v[r][j][2] += bf_lo(w.y); v[r][j][3] += bf_hi(w.y);
                s += (v[r][j][0] * v[r][j][0] + v[r][j][1] * v[r][j][1]) + (v[r][j][2] * v[r][j][2] + v[r][j][3] * v[r][j][3]); }
            { const int mh = m0 + r * NGW;
              if (mh < T) { u32x2* hr = (u32x2*)(a.out + (size_t)mh * D) + lane;
#pragma unroll
                  for (int j = 0; j < 8; ++j) { u32x2 o; o.x = pk2(v[r][j][0], v[r][j][1]); o.y = pk2(v[r][j][2], v[r][j][3]); hr[64 * j] = o; } } }
            const float rstd = 1.0f / sqrtf(wave_sum(s) * (1.0f / D) + EPS);
            const float* gmp = gm; asm volatile("" : "+s"(gmp));
#pragma unroll
            for (int j = 0; j < 8; ++j) { const f32x4 g = ((const f32x4*)gmp)[lane + 64 * j]; v[r][j] = v[r][j] * g * rstd; }
            const int m = m0 + r * NGW;
            if (m < T) { unsigned* o4 = (unsigned*)(V + (size_t)m * D) + lane;
#pragma unroll
                for (int j = 0; j < 8; ++j) { int w = 0; w = __builtin_amdgcn_cvt_pk_fp8_f32(v[r][j][0], v[r][j][1], w, false); w = __builtin_amdgcn_cvt_pk_fp8_f32(v[r][j][2], v[r][j][3], w, true); o4[64 * j] = (unsigned)w; } } }
        float lg0 = 0.f, lg1 = 0.f;
#pragma unroll 1
        for (int e = 0; e < NE; ++e) { float a0 = 0.f, a1 = 0.f; const LAS float* we = wt + e * D + 4 * lane;
#pragma unroll
            for (int j = 0; j < 8; ++j) { const f32x4 w = *(const LAS f32x4*)(we + 256 * j);
                a0 += (v[0][j][0] * w[0] + v[0][j][1] * w[1]) + (v[0][j][2] * w[2] + v[0][j][3] * w[3]); a1 += (v[1][j][0] * w[0] + v[1][j][1] * w[1]) + (v[1][j][2] * w[2] + v[1][j][3] * w[3]); }
            a0 = wave_sum(a0); a1 = wave_sum(a1); if (eL == e) { lg0 = a0; lg1 = a1; } }
#pragma unroll
        for (int r = 0; r < 2; ++r) { const float lg = r ? lg1 : lg0; float mx = lg;
            mx = fmaxf(mx, dpp_mov<0x141>(mx)); mx = fmaxf(mx, dpp_mov<0x140>(mx));
            mx = fmaxf(fmaxf(lane_val(mx, 0), lane_val(mx, 16)), fmaxf(lane_val(mx, 32), lane_val(mx, 48)));
            const float ex = expf(lg - mx); float den = ex;
            den += dpp_mov<0x141>(den); den += dpp_mov<0x140>(den);
            den = (lane_val(den, 0) + lane_val(den, 16)) + (lane_val(den, 32) + lane_val(den, 48));
            const int m = m0 + r * NGW;
            if (m < T && (lane & 3) == 0) AFF[((size_t)(m >> 11) * NE + eL) * SEQ + (m & (SEQ - 1))] = ex / den; }
    }
    __syncthreads();
}

__device__ __forceinline__ void p7_topk(const Args& a, LAS unsigned char* lds, int G, const int tid) {
    LAS unsigned* red = (LAS unsigned*)lds;
    const int lane = tid & 63, wave = tid >> 6;
    const float* AFF = (const float*)(a.ws + WS_AFF); int* IDX = (int*)(a.ws + WS_IDX); float* GATE = (float*)(a.ws + WS_GATE); int* INV = (int*)(a.ws + WS_INV);
    for (int p = blockIdx.x; p < NPAN; p += G) {
        const int b = p >> 4, e = p & 15;
        unsigned v[4];
#pragma unroll
        for (int k = 0; k < 4; ++k) v[k] = __builtin_bit_cast(unsigned, AFF[((size_t)b * NE + e) * SEQ + 4 * tid + k]);
        unsigned prefix = 0u;
        for (int bit = 30; bit >= 0; --bit) {
            const unsigned Tt = prefix | (1u << bit); unsigned c = 0;
#pragma unroll
            for (int k = 0; k < 4; ++k) c += (unsigned)__popcll(__ballot(v[k] >= Tt));
            LAS unsigned* rb = red + (bit & 1) * 8;
            if (lane == 0) rb[wave] = c;
            LDS_WAIT(); __syncthreads();
            unsigned tot = 0;
#pragma unroll
            for (int w = 0; w < 8; ++w) tot += rb[w];
            if (tot >= (unsigned)CAP) prefix = Tt;
        }
        unsigned cg_ = 0, ce_ = 0;
#pragma unroll
        for (int k = 0; k < 4; ++k) { cg_ += v[k] > prefix; ce_ += v[k] == prefix; }
        unsigned sg = cg_, se = ce_;
#pragma unroll
        for (int o = 1; o < 64; o <<= 1) { const unsigned tg = __shfl_up(sg, o), te = __shfl_up(se, o); if (lane >= o) { sg += tg; se += te; } }
        LAS unsigned* sc = red + 64;
        __syncthreads();
        if (lane == 63) { sc[wave] = sg; sc[8 + wave] = se; }
        LDS_WAIT(); __syncthreads();
        unsigned bg = 0, be = 0, totg = 0;
#pragma unroll
        for (int w = 0; w < 8; ++w) { const unsigned xg = sc[w], xe = sc[8 + w]; if (w < wave) { bg += xg; be += xe; } totg += xg; }
        unsigned eg = bg + sg - cg_, ee = be + se - ce_;
        const unsigned need = (unsigned)CAP - totg;
#pragma unroll
        for (int k = 0; k < 4; ++k) { const int n = 4 * tid + k; int slot = -1;
            if (v[k] > prefix) { slot = (int)eg; ++eg; }
            else if (v[k] == prefix) { if (ee < need) slot = (int)(totg + ee); ++ee; }
            if (slot >= 0) { IDX[p * CAP + slot] = n; GATE[p * CAP + slot] = __builtin_bit_cast(float, v[k]); }
            INV[(size_t)(b * SEQ + n) * NE + e] = slot; }
        __syncthreads();
    }
}

__device__ __forceinline__ void p8_gather(const Args& a, int gw, int NGW, int lane) {
    const bf16_t* V = (const bf16_t*)(a.ws + WS_RA); bf16_t* Xs = (bf16_t*)(a.ws + WS_RD); const int* IDX = (const int*)(a.ws + WS_IDX);
    for (int r = gw; r < NPAN * CAP; r += NGW) { const int p = r >> 8, b = p >> 4; const int n = IDX[r];
        const u32x4* src = (const u32x4*)(V + (size_t)(b * SEQ + n) * D) + lane; u32x4* dst = (u32x4*)(Xs + (size_t)r * D) + lane;
        u32x4 t[4];
#pragma unroll
        for (int j = 0; j < 4; ++j) t[j] = src[64 * j];
#pragma unroll
        for (int j = 0; j < 4; ++j) dst[64 * j] = t[j]; }
}

__device__ __forceinline__ void p11_final(const Args& a, int gw, int NGW, int lane, float* dst) {
    float* out = a.out; const unsigned char* Y = (const unsigned char*)(a.ws + WS_RD); const int* INV = (const int*)(a.ws + WS_INV); const float* gf = a.in[I_NFINAL];
    for (int m = gw; m < T; m += NGW) { f32x4* xr = (f32x4*)(dst + (size_t)m * D) + lane; const u32x2* dr = (const u32x2*)(out + (size_t)m * D) + lane; f32x4 v[8];
#pragma unroll
        for (int j = 0; j < 8; ++j) { const u32x2 w = dr[64 * j]; v[j][0] = bf_lo(w.x); v[j][1] = bf_hi(w.x); v[j][2] = bf_lo(w.y); v[j][3] = bf_hi(w.y); }
        const int b = m >> 11;
        i32x4 iv[4];
#pragma unroll
        for (int q = 0; q < 4; ++q) iv[q] = *(const i32x4*)(INV + (size_t)m * NE + 4 * q);
#pragma unroll
        for (int e = 0; e < NE; ++e) { const int slot = __builtin_amdgcn_readfirstlane(iv[e >> 2][e & 3]);
            if (slot >= 0) { const unsigned* yr = (const unsigned*)(Y + ((size_t)(b * NE + e) * CAP + slot) * D) + lane;
#pragma unroll
                for (int j = 0; j < 8; ++j) { const unsigned w = yr[64 * j]; const f32x2 lo = __builtin_amdgcn_cvt_pk_f32_fp8((int)w, false), hi = __builtin_amdgcn_cvt_pk_f32_fp8((int)w, true);
                    v[j][0] += lo[0] * (1.0f / YSC); v[j][1] += lo[1] * (1.0f / YSC); v[j][2] += hi[0] * (1.0f / YSC); v[j][3] += hi[1] * (1.0f / YSC); } } }
        float s = 0.f;
#pragma unroll
        for (int j = 0; j < 8; ++j) s += (v[j][0] * v[j][0] + v[j][1] * v[j][1]) + (v[j][2] * v[j][2] + v[j][3] * v[j][3]);
        const float rstd = 1.0f / sqrtf(wave_sum(s) * (1.0f / D) + EPS);
#pragma unroll
        for (int j = 0; j < 8; ++j) { const f32x4 g = ((const f32x4*)gf)[lane + 64 * j]; __builtin_nontemporal_store(v[j] * g * rstd, xr + 64 * j); } }
}

#define XB_TMO      128
#define XB_XCNT(j)  (256  + 64 * (j))
#define XB_XSUB(j)  (1280 + 64 * (j))
#define XB_XGEN(j)  (2304 + 64 * (j))
#define XB_TOP      3328
#define XB_TOPGEN   3392
#define XCD_BAR_WORDS 3456
#define XB_SPIN_CAP (1u << 22)
__device__ __forceinline__ unsigned xb_ld(unsigned* p)              { return __hip_atomic_load(p, __ATOMIC_RELAXED, __HIP_MEMORY_SCOPE_AGENT); }
__device__ __forceinline__ unsigned xb_add(unsigned* p, unsigned v) { return __hip_atomic_fetch_add(p, v, __ATOMIC_RELAXED, __HIP_MEMORY_SCOPE_AGENT); }
__device__ __forceinline__ unsigned xb_xcc_id() { return (unsigned)__builtin_amdgcn_s_getreg((3 << 11) | 20) & 0xFu; }
#define XB_SPIN(cond, bar) do { unsigned _sp = 0; while (cond) { __builtin_amdgcn_s_sleep(1); \
    if ((++_sp & 255u) == 0u) { if (xb_ld(&(bar)[XB_TMO])) break; if (_sp > XB_SPIN_CAP) { atomicAdd(&(bar)[XB_TMO], 1u); break; } } } } while (0)
struct XcdBarrier { unsigned* bar; unsigned x; volatile LAS unsigned* st; };
__device__ __forceinline__ XcdBarrier xcd_barrier_post(unsigned* bar, volatile LAS unsigned* st) {
    XcdBarrier b; b.bar = bar; b.x = xb_xcc_id(); b.st = st;
    if (threadIdx.x == 0) (void)xb_add(&bar[XB_XCNT(b.x)], 1u);
    return b;
}
__device__ __forceinline__ void xcd_barrier_complete(unsigned* bar, unsigned x, unsigned& nloc, unsigned& nx) {
    const unsigned G = gridDim.x * gridDim.y * gridDim.z;
    unsigned sum, cnt, mine, sp = 0u;
    for (;;) {
        sum = 0u; cnt = 0u; mine = 0u;
#pragma unroll
        for (unsigned j = 0; j < 16; ++j) { const unsigned c = xb_ld(&bar[XB_XCNT(j)]); sum += c; cnt += (c > 0u) ? 1u : 0u; mine = (j == x) ? c : mine; }
        if (sum == G) break;
        __builtin_amdgcn_s_sleep(1);
        if ((++sp & 255u) == 0u) { if (xb_ld(&bar[XB_TMO])) break; if (sp > XB_SPIN_CAP) { atomicAdd(&bar[XB_TMO], 1u); break; } }
    }
    nloc = mine > 0u ? mine : 1u; nx = cnt > 0u ? cnt : 1u;
}
__device__ __forceinline__ void xcd_barrier(const XcdBarrier& b) {
    asm volatile("s_waitcnt vmcnt(0)" ::: "memory");
    __syncthreads();
    if (threadIdx.x == 0) {
        unsigned* bar = b.bar;
        __builtin_amdgcn_s_waitcnt(0);
        unsigned nloc = b.st[0], nx = b.st[1];
        if (nloc == 0u) { xcd_barrier_complete(bar, b.x, nloc, nx); b.st[0] = nloc; b.st[1] = nx; }
        const unsigned old = xb_add(&bar[XB_XSUB(b.x)], 1u);
        const unsigned gen = old / nloc;
        if (old + 1u == (gen + 1u) * nloc) {
            __builtin_amdgcn_fence(__ATOMIC_RELEASE, "agent");
            asm volatile("s_waitcnt vmcnt(0)" ::: "memory");
            const unsigned og = xb_add(&bar[XB_TOP], 1u);
            const unsigned tg = og / nx;
            if (og + 1u == (tg + 1u) * nx) xb_add(&bar[XB_TOPGEN], 1u);
            else XB_SPIN(xb_ld(&bar[XB_TOPGEN]) == tg, bar);
            __builtin_amdgcn_fence(__ATOMIC_ACQUIRE, "agent");
            xb_add(&bar[XB_XGEN(b.x)], 1u);
            asm volatile("s_waitcnt vmcnt(0)" ::: "memory");
        } else {
            XB_SPIN(xb_ld(&bar[XB_XGEN(b.x)]) == gen, bar);
            __builtin_amdgcn_fence(__ATOMIC_ACQUIRE, "agent");
            asm volatile("s_waitcnt vmcnt(0)" ::: "memory");
        }
    }
    __syncthreads();
}

__global__ void __launch_bounds__(NTHR, 2) fwd_kernel(Args args) {
    extern __shared__ __attribute__((aligned(16))) unsigned char lds_raw[];
    LAS unsigned char* lds = (LAS unsigned char*)lds_raw;
    volatile LAS unsigned* misc = (volatile LAS unsigned*)(lds + MISC_OFF);
    if (threadIdx.x < 64) misc[threadIdx.x] = 0u;
    __syncthreads();
    XcdBarrier xbar = xcd_barrier_post((unsigned*)args.ws, misc);
    const int G = gridDim.x, bx = blockIdx.x;
    const int vcu = (G % 8 == 0) ? (bx % 8) * (G / 8) + bx / 8 : bx;
    constexpr unsigned SEAMS = (1u << 0) | (1u << 7) | (1u << 8) | (1u << 10) | (1u << 11) | (1u << 12) | (1u << 13) | (1u << 14) | (1u << 15) | (1u << 16);
    const int slot = (bx % 8) >> 1;
    if (PROBE_SEL >= 0 && bx == 0 && threadIdx.x == 0) misc[7] = (unsigned)__builtin_amdgcn_s_memrealtime();
    for (int pos = args.ph_lo, rep = 0; pos < args.ph_hi; ) {
        int tid = threadIdx.x; asm volatile("" : "+v"(tid));
        int Gs = G; asm volatile("" : "+s"(Gs));
        const int lane = tid & 63, wave = __builtin_amdgcn_readfirstlane(tid >> 6);
        const int gw = vcu * NWAVES + wave, NGW = Gs * NWAVES;
        int step = pos;
        if (pos >= 4 && pos <= 7) { const int q = pos - 4; step = (q == slot) ? 100 : 4 + (q < slot ? q : q - 1); } else if (pos > 7) step = pos - 1;
        int gid = -1;
        switch (step) {
        case 0: p0_prologue(args, lds, gw, NGW, wave, lane); break;
        case 100: p0_items(args, lds, gw, NGW, wave, lane, P0_NBASE, P0_NITEMS); LDS_WAIT(); __syncthreads(); break;
        case 1: gid = G_MGU; break; case 2: gid = G_MGV; break; case 3: gid = G_MGP; break;
        case 4: gid = G_1A; break; case 5: gid = G_1B; break; case 6: gid = G_1C; break;
        case 7: p3_fold(args, gw, NGW, lane); p3_pool(args, gw * 64 + lane, NGW * 64); break;
        case 8: gid = G_DFTU; break; case 9: gid = G_DFTV; break;
        case 10: gid = G_4; break;
        case 11: gid = G_OUT; break;
        case 12: p6_rows(args, lds, gw, NGW, lane, tid); break;
        case 13: p7_topk(args, lds, Gs, tid); break;
        case 14: gid = G_GU; break;
        case 15: gid = G_DOWN; break;
        default: p11_final(args, gw, NGW, lane, args.out); break;
        }
        if (gid >= 0) { GemmDesc d_; make_desc(gid, args, d_); if (gid == G_GU) gemm_run<true, false, true>(lds, d_, Gs, bx, tid); else if (gid == G_DOWN || gid == G_1C) gemm_run<false, false, true>(lds, d_, Gs, bx, tid); else gemm_run<false, true, false>(lds, d_, Gs, bx, tid); }
        if (((PROBE_MASK >> pos) & 1u) && rep == 0) { rep = 1; xcd_barrier(xbar); continue; }
        rep = 0;
        if (((SEAMS >> pos) & 1u) && pos + 1 < args.ph_hi) xcd_barrier(xbar);
        ++pos;
        if (PROBE_SEL >= 0 && bx == 0 && tid == 0) misc[8 + pos] = (unsigned)__builtin_amdgcn_s_memrealtime();
    }
    if (PROBE_SEL >= 0 && bx == 0) { __syncthreads(); if (threadIdx.x == 0) { const unsigned t0 = (PROBE_SEL == 0) ? misc[7] : misc[8 + PROBE_SEL], t1 = misc[8 + PROBE_SEL_END];
        asm volatile("s_waitcnt vmcnt(0)" ::: "memory"); args.out[0] += (float)(t1 - t0) * 0.001f; } }
}

extern "C" void kernel_launch(void* const* d_in, const int* in_sizes, int n_in, void* d_out, int out_size, void* d_ws, size_t ws_size, hipStream_t stream) {
    static int grid = 0;
    if (grid == 0) {
        if (n_in != 17 || in_sizes[0] != T * D || out_size != T * D || ws_size < WS_END) { fprintf(stderr, "kernel_launch: unexpected shapes (n_in %d, in0 %d, out %d, ws %zu < %zu); nothing launched\n", n_in, n_in > 0 ? in_sizes[0] : -1, out_size, ws_size, (size_t)WS_END); grid = -1; return; }
        int dev = 0, cus = 0, per_cu = 0;
        if (hipGetDevice(&dev) != hipSuccess || hipDeviceGetAttribute(&cus, hipDeviceAttributeMultiprocessorCount, dev) != hipSuccess) { grid = -1; return; }
        if (hipFuncSetAttribute((const void*)fwd_kernel, hipFuncAttributeMaxDynamicSharedMemorySize, LDS_BYTES) != hipSuccess) { fprintf(stderr, "kernel_launch: hipFuncSetAttribute failed\n"); grid = -1; return; }
        if (hipOccupancyMaxActiveBlocksPerMultiprocessor(&per_cu, (const void*)fwd_kernel, NTHR, LDS_BYTES) != hipSuccess || per_cu < 1) { fprintf(stderr, "kernel_launch: occupancy query failed (%d)\n", per_cu); (void)hipGetLastError(); grid = -1; return; }
        grid = cus * per_cu;
        fprintf(stderr, "kernel_launch: %d CUs x %d per CU = grid %d\n", cus, per_cu, grid);
    }
    if (grid < 0) return;
    if (hipMemsetAsync(d_ws, 0, CTL_ZERO_BYTES, stream) != hipSuccess) { fprintf(stderr, "kernel_launch: hipMemsetAsync failed\n"); return; }
    Args a; memset(&a, 0, sizeof(a));
    for (int i = 0; i < 17; ++i) a.in[i] = (const float*)d_in[i];
    a.out = (float*)d_out; a.ws = (unsigned char*)d_ws;
    if (MK_N_LAUNCHES == 1) {
        a.ph_lo = 0; a.ph_hi = N_STEPS; void* kargs[] = {&a};
        hipError_t e = hipLaunchCooperativeKernel((const void*)fwd_kernel, dim3(grid), dim3(NTHR), kargs, LDS_BYTES, stream);
        if (e != hipSuccess) fprintf(stderr, "kernel_launch: cooperative launch failed: %s (grid %d)\n", hipGetErrorString(e), grid);
    } else {
        static const int cuts[12] = {0, 1, 8, 9, 11, 12, 13, 14, 15, 16, 17, 18};
        for (int p = 0; p < 11; ++p) { a.ph_lo = cuts[p]; a.ph_hi = cuts[p + 1]; void* kargs[] = {&a};
            hipError_t e = hipLaunchCooperativeKernel((const void*)fwd_kernel, dim3(grid), dim3(NTHR), kargs, LDS_BYTES, stream);
            if (e != hipSuccess) { fprintf(stderr, "kernel_launch: launch %d failed: %s (grid %d)\n", p, hipGetErrorString(e), grid); break; } }
    }
}
```
